# Optimizing an MI355X kernel written in HIP

```python
import math
import jax, jax.numpy as jnp
from jax import lax
import numpy as np

D_MODEL = 2048
BATCH = 8
SEQ = 2048
DEPTH = 2

ALPHA = (2.0 * DEPTH) ** 0.25
BETA = (8.0 * DEPTH) ** -0.25
LN_EPS = 1e-5

HEAD_DIM = 64
N_HEADS = D_MODEL // HEAD_DIM
N_KV = N_HEADS // 8
GROUP = N_HEADS // N_KV
WINDOW = 128
BLOCK = 128
QKV_DIM = (N_HEADS + 2 * N_KV) * HEAD_DIM

POOL_WINDOWS = (2, 4, 8, 16)
N_POOL_GROUPS = len(POOL_WINDOWS)
POOL_GC = D_MODEL // N_POOL_GROUPS

N_KEYS = 128
N_EXPERTS = N_KEYS * N_KEYS
PEER_HEADS = 8
PEER_TOPK = 16
PEER_DK = 128
PEER_CHUNK = 128

N_ATTN_LAYERS = (DEPTH + 1) // 2
N_POOL_LAYERS = DEPTH // 2

kernel_name = "hybrid_swa_pool_peer_deepnorm"


def layer_norm(x, g, b):
    xf = x.astype(jnp.float32)
    mu = jnp.mean(xf, axis=-1, keepdims=True)
    var = jnp.mean(jnp.square(xf - mu), axis=-1, keepdims=True)
    y = (xf - mu) * lax.rsqrt(var + LN_EPS)
    return (y * g.astype(jnp.float32) + b.astype(jnp.float32)).astype(x.dtype)


def alibi_slopes(n):
    return np.array([2.0 ** (-8.0 * (h + 1) / n) for h in range(n)], dtype=np.float32)


def swa_attention(x, w_qkv, w_o, sinks):
    B, S, _ = x.shape
    nb = S // BLOCK
    qkv = x @ w_qkv
    q = qkv[..., : N_HEADS * HEAD_DIM]
    k = qkv[..., N_HEADS * HEAD_DIM:(N_HEADS + N_KV) * HEAD_DIM]
    v = qkv[..., (N_HEADS + N_KV) * HEAD_DIM:]
    q = q.reshape(B, nb, BLOCK, N_KV, GROUP, HEAD_DIM)
    k = k.reshape(B, nb, BLOCK, N_KV, HEAD_DIM)
    v = v.reshape(B, nb, BLOCK, N_KV, HEAD_DIM)
    pad = ((0, 0), (1, 0), (0, 0), (0, 0), (0, 0))
    kb = jnp.concatenate([jnp.pad(k, pad)[:, :-1], k], axis=2)
    vb = jnp.concatenate([jnp.pad(v, pad)[:, :-1], v], axis=2)

    scores = jnp.einsum('bnqkgd,bnskd->bnkgqs', q, kb).astype(jnp.float32)
    scores = scores * (1.0 / math.sqrt(HEAD_DIM))

    dist = (np.arange(BLOCK)[:, None] + BLOCK) - np.arange(2 * BLOCK)[None, :]
    band = (dist >= 0) & (dist < WINDOW)
    s_abs = (np.arange(nb)[:, None] - 1) * BLOCK + np.arange(2 * BLOCK)[None, :]
    mask = band[None] & (s_abs >= 0)[:, None, :]
    slopes = jnp.asarray(alibi_slopes(N_HEADS).reshape(N_KV, GROUP))
    alibi = -slopes[:, :, None, None] * jnp.asarray(dist.astype(np.float32))

    scores = jnp.where(mask[None, :, None, None], scores + alibi[None, None], -1e30)
    sink = sinks.astype(jnp.float32).reshape(N_KV, GROUP)[None, None, :, :, None, None]
    m = jnp.maximum(jnp.max(scores, axis=-1, keepdims=True), sink)
    e = jnp.exp(scores - m)
    p = e / (jnp.sum(e, axis=-1, keepdims=True) + jnp.exp(sink - m))

    out = jnp.einsum('bnkgqs,bnskd->bnqkgd', p.astype(vb.dtype), vb)
    out = out.reshape(B, S, N_HEADS * HEAD_DIM)
    return out @ w_o


def multiscale_pool(x, w_pool, scale):
    B, S, D = x.shape
    t = np.arange(S)
    c = jnp.cumsum(x.astype(jnp.float32), axis=1)
    c = jnp.pad(c, ((0, 0), (1, 0), (0, 0)))
    pooled = []
    for g, w in enumerate(POOL_WINDOWS):
        cg = c[..., g * POOL_GC:(g + 1) * POOL_GC]
        lo_idx = np.maximum(t + 1 - w, 0)
        cnt = np.minimum(t + 1, w).astype(np.float32)
        mean = (cg[:, 1:] - cg[:, lo_idx]) / jnp.asarray(cnt)[None, :, None]
        pooled.append(mean)
    pooled = jnp.stack(pooled, axis=2)
    mix = (pooled - x.astype(jnp.float32).reshape(B, S, N_POOL_GROUPS, POOL_GC)).astype(x.dtype)
    y = jnp.einsum('bsgc,gcd->bsgd', mix, w_pool).reshape(B, S, D)
    return y * scale


def peer(x2d, w_query, sub_keys, u_tab, v_tab):
    T, D = x2d.shape
    xc = x2d.reshape(T // PEER_CHUNK, PEER_CHUNK, D)

    def chunk(xb):
        C = xb.shape[0]
        q = (xb @ w_query).reshape(C, PEER_HEADS, 2, PEER_DK)
        s = jnp.einsum('chpd,hpnd->chpn', q, sub_keys).astype(jnp.float32)
        sv, si = lax.top_k(s, PEER_TOPK)
        cand = sv[:, :, 0, :, None] + sv[:, :, 1, None, :]
        cand_idx = si[:, :, 0, :, None] * N_KEYS + si[:, :, 1, None, :]
        cand = cand.reshape(C, PEER_HEADS, PEER_TOPK * PEER_TOPK)
        cand_idx = cand_idx.reshape(C, PEER_HEADS, PEER_TOPK * PEER_TOPK)
        best, pos = lax.top_k(cand, PEER_TOPK)
        idx = jnp.take_along_axis(cand_idx, pos, axis=-1)
        gate = jax.nn.softmax(best, axis=-1).astype(xb.dtype)
        u = u_tab[idx]
        h = jnp.einsum('chkd,cd->chk', u, xb)
        a = gate * jax.nn.gelu(h, approximate=False)
        v = v_tab[idx]
        return jnp.einsum('chk,chkd->cd', a, v)

    return lax.map(chunk, xc).reshape(T, D)


def setup_inputs(seed: int = 0) -> dict:
    key = jax.random.key(seed)
    ks = jax.random.split(key, 14)
    f32 = jnp.float32
    x = jax.random.normal(ks[0], (BATCH, SEQ, D_MODEL), f32)

    w_qkv = jax.random.normal(ks[1], (N_ATTN_LAYERS, D_MODEL, QKV_DIM), f32) * D_MODEL ** -0.5
    col_scale = jnp.concatenate([jnp.ones(((N_HEADS + N_KV) * HEAD_DIM,), f32),
                                 jnp.full((N_KV * HEAD_DIM,), BETA, f32)])
    w_qkv = w_qkv * col_scale
    w_o = jax.random.normal(ks[2], (N_ATTN_LAYERS, N_HEADS * HEAD_DIM, D_MODEL), f32) * (
        (N_HEADS * HEAD_DIM) ** -0.5 * BETA)
    sinks = jax.random.normal(ks[3], (N_ATTN_LAYERS, N_HEADS), f32) * 0.5

    pool_w = jax.random.normal(ks[4], (N_POOL_LAYERS, N_POOL_GROUPS, POOL_GC, POOL_GC), f32) * (
        POOL_GC ** -0.5 * BETA)
    pool_scale = 1.0 + 0.02 * jax.random.normal(ks[5], (N_POOL_LAYERS, D_MODEL), f32)

    ln_gain = 1.0 + 0.02 * jax.random.normal(ks[6], (DEPTH, 2, D_MODEL), f32)
    ln_bias = 0.02 * jax.random.normal(ks[7], (DEPTH, 2, D_MODEL), f32)

    peer_w_query = jax.random.normal(ks[8], (DEPTH, D_MODEL, PEER_HEADS * 2 * PEER_DK), f32) * D_MODEL ** -0.5
    peer_sub_keys = jax.random.normal(ks[9], (DEPTH, PEER_HEADS, 2, N_KEYS, PEER_DK), f32) * PEER_DK ** -0.5
    peer_u = jax.random.normal(ks[10], (DEPTH, N_EXPERTS, D_MODEL), f32) * D_MODEL ** -0.5
    peer_v = jax.random.normal(ks[11], (DEPTH, N_EXPERTS, D_MODEL), f32) * (PEER_HEADS ** -0.5 * BETA)
    return {"x": x, "attn_w_qkv": w_qkv, "attn_w_o": w_o, "attn_sinks": sinks,
            "pool_w": pool_w, "pool_scale": pool_scale, "ln_gain": ln_gain, "ln_bias": ln_bias,
            "peer_w_query": peer_w_query, "peer_sub_keys": peer_sub_keys,
            "peer_u": peer_u, "peer_v": peer_v}


def reference(x, attn_w_qkv, attn_w_o, attn_sinks, pool_w, pool_scale, ln_gain, ln_bias,
              peer_w_query, peer_sub_keys, peer_u, peer_v):
    B, S, D = x.shape
    for i in range(DEPTH):
        j = i // 2
        if i % 2 == 0:
            mix = swa_attention(x, attn_w_qkv[j], attn_w_o[j], attn_sinks[j])
        else:
            mix = multiscale_pool(x, pool_w[j], pool_scale[j])
        x = layer_norm(ALPHA * x + mix, ln_gain[i, 0], ln_bias[i, 0])
        f = peer(x.reshape(B * S, D), peer_w_query[i], peer_sub_keys[i], peer_u[i], peer_v[i])
        x = layer_norm(ALPHA * x + f.reshape(B, S, D), ln_gain[i, 1], ln_bias[i, 1])
    return x
```

```cpp
#include <hip/hip_runtime.h>
#include <hip/hip_cooperative_groups.h>
#include <cstdio>
namespace cg = cooperative_groups;

#ifndef MULTI
#define MULTI 1
#endif

typedef unsigned short u16;
using bfx8 = __attribute__((ext_vector_type(8))) __bf16;
using bfx2 = __attribute__((ext_vector_type(2))) __bf16;
using f32x4 = __attribute__((ext_vector_type(4))) float;
using f32x16 = __attribute__((ext_vector_type(16))) float;

constexpr int NT = 512;
constexpr int TOK = 16384, DM = 2048, QKVD = 2560;
constexpr float ALPHA = 1.41421356237309515f;
constexpr float LN_EPS = 1e-5f;
constexpr int LDS_BYTES = 137216;
constexpr int NPHASE = 12;

struct Params {
  const float *x, *w_qkv, *w_o, *sinks, *pool_w, *pool_scale, *ln_g, *ln_b, *wq, *subkeys, *pu, *pv;
  float* out;
  u16 *wt_qkv, *wt_o, *wt_pool, *wt_q, *sk, *ub, *vb, *xb, *qkv, *att;
  float *xf, *y, *pk_gate;
  int* pk_idx;
};

__device__ __forceinline__ u16 f2bf(float f) {
  unsigned u = __float_as_uint(f);
  u += 0x7FFFu + ((u >> 16) & 1u);
  return (u16)(u >> 16);
}
__device__ __forceinline__ unsigned pack2bf(float a, float b) {
  return (unsigned)f2bf(a) | ((unsigned)f2bf(b) << 16);
}
__device__ __forceinline__ float bflo(unsigned w) { return __uint_as_float(w << 16); }
__device__ __forceinline__ float bfhi(unsigned w) { return __uint_as_float(w & 0xFFFF0000u); }
__device__ __forceinline__ float dot2(unsigned a, unsigned b, float c) {
  return __builtin_amdgcn_fdot2_f32_bf16(__builtin_bit_cast(bfx2, a), __builtin_bit_cast(bfx2, b), c, false);
}
__device__ __forceinline__ float clr7(float v) { return __uint_as_float(__float_as_uint(v) & ~127u); }

#define INSERT16(L, xx)                              \
  {                                                  \
    float _x = (xx);                                 \
    _Pragma("unroll") for (int _i = 0; _i < 16; _i++) { \
      float _h = fmaxf(L[_i], _x);                   \
      _x = fminf(L[_i], _x);                         \
      L[_i] = _h;                                    \
    }                                                \
  }

__device__ void transpose_cvt(const float* __restrict__ src, u16* __restrict__ dst, int K, int N, float* tile) {
  const int tilesN = N / 64, nt = tilesN * (K / 64);
  const int tid = threadIdx.x;
  for (int t = blockIdx.x; t < nt; t += gridDim.x) {
    const int k0 = (t / tilesN) * 64, n0 = (t % tilesN) * 64;
    __syncthreads();
#pragma unroll
    for (int i = 0; i < 2; i++) {
      const int r = (tid >> 4) + i * 32, c4 = (tid & 15) * 4;
      const float4 v = *(const float4*)(src + (size_t)(k0 + r) * N + n0 + c4);
      tile[r * 65 + c4 + 0] = v.x;
      tile[r * 65 + c4 + 1] = v.y;
      tile[r * 65 + c4 + 2] = v.z;
      tile[r * 65 + c4 + 3] = v.w;
    }
    __syncthreads();
    const int n = tid >> 3, kc = (tid & 7) * 8;
    uint4 o;
    o.x = pack2bf(tile[(kc + 0) * 65 + n], tile[(kc + 1) * 65 + n]);
    o.y = pack2bf(tile[(kc + 2) * 65 + n], tile[(kc + 3) * 65 + n]);
    o.z = pack2bf(tile[(kc + 4) * 65 + n], tile[(kc + 5) * 65 + n]);
    o.w = pack2bf(tile[(kc + 6) * 65 + n], tile[(kc + 7) * 65 + n]);
    *(uint4*)(dst + (size_t)(n0 + n) * K + k0 + kc) = o;
  }
}

__device__ void cvt_bf16(const float* __restrict__ src, u16* __restrict__ dst, size_t n) {
  const size_t nch = n / 8;
  for (size_t i = (size_t)blockIdx.x * NT + threadIdx.x; i < nch; i += (size_t)gridDim.x * NT) {
    const float4 a = ((const float4*)src)[2 * i], b = ((const float4*)src)[2 * i + 1];
    uint4 o;
    o.x = pack2bf(a.x, a.y);
    o.y = pack2bf(a.z, a.w);
    o.z = pack2bf(b.x, b.y);
    o.w = pack2bf(b.z, b.w);
    ((uint4*)dst)[i] = o;
  }
}

__device__ void phase_prep(const Params& p, char* lds) {
  float* tile = (float*)lds;
  transpose_cvt(p.w_qkv, p.wt_qkv, 2048, 2560, tile);
  transpose_cvt(p.w_o, p.wt_o, 2048, 2048, tile);
  for (int g = 0; g < 4; g++) transpose_cvt(p.pool_w + (size_t)g * 512 * 512, p.wt_pool + (size_t)g * 512 * 512, 512, 512, tile);
  for (int l = 0; l < 2; l++) transpose_cvt(p.wq + (size_t)l * 2048 * 2048, p.wt_q + (size_t)l * 2048 * 2048, 2048, 2048, tile);
  cvt_bf16(p.subkeys, p.sk, (size_t)2 * 8 * 2 * 128 * 128);
  cvt_bf16(p.x, p.xb, (size_t)TOK * DM);
  cvt_bf16(p.pu, p.ub, (size_t)2 * 16384 * 2048);
  cvt_bf16(p.pv, p.vb, (size_t)2 * 16384 * 2048);
}

__device__ __forceinline__ int swz(int row, int c) { return row * 128 + ((c ^ ((row >> 1) & 7)) << 4); }

__device__ __forceinline__ void gemm_mainloop(const u16* __restrict__ A, int lda, const u16* __restrict__ B, int ldb,
                                              int K, char* lds, f32x4 (&acc)[4][4]) {
  const int tid = threadIdx.x, lane = tid & 63, wave = tid >> 6;
  const int wm = wave >> 2, wn = wave & 3;
  const int fr = lane & 15, fq = lane >> 4;
  const int srow = tid >> 3, sc = tid & 7;
  const u16* ga = A + (size_t)srow * lda + sc * 8;
  const u16* gb = B + (size_t)srow * ldb + sc * 8;
  const int soff = swz(srow, sc);
  uint4 ra[2], rb[4];
  const int nk = K >> 6;
#pragma unroll
  for (int i = 0; i < 2; i++) ra[i] = *(const uint4*)(ga + (size_t)(i * 64) * lda);
#pragma unroll
  for (int i = 0; i < 4; i++) rb[i] = *(const uint4*)(gb + (size_t)(i * 64) * ldb);
#pragma unroll
  for (int i = 0; i < 2; i++) *(uint4*)(lds + soff + i * 8192) = ra[i];
#pragma unroll
  for (int i = 0; i < 4; i++) *(uint4*)(lds + 16384 + soff + i * 8192) = rb[i];
  __syncthreads();
  for (int kt = 0; kt < nk; kt++) {
    if (kt + 1 < nk) {
#pragma unroll
      for (int i = 0; i < 2; i++) ra[i] = *(const uint4*)(ga + (size_t)(i * 64) * lda + (kt + 1) * 64);
#pragma unroll
      for (int i = 0; i < 4; i++) rb[i] = *(const uint4*)(gb + (size_t)(i * 64) * ldb + (kt + 1) * 64);
    }
    const char* ab = lds + (kt & 1) * 49152;
    const char* bb = ab + 16384;
#pragma unroll
    for (int ks = 0; ks < 2; ks++) {
      const int co = ((ks * 4 + fq) ^ ((fr >> 1) & 7)) << 4;
      bfx8 wf[4], xf[4];
#pragma unroll
      for (int i = 0; i < 4; i++) wf[i] = *(const bfx8*)(bb + (wn * 64 + i * 16 + fr) * 128 + co);
#pragma unroll
      for (int j = 0; j < 4; j++) xf[j] = *(const bfx8*)(ab + (wm * 64 + j * 16 + fr) * 128 + co);
#pragma unroll
      for (int i = 0; i < 4; i++)
#pragma unroll
        for (int j = 0; j < 4; j++) acc[i][j] = __builtin_amdgcn_mfma_f32_16x16x32_bf16(wf[i], xf[j], acc[i][j], 0, 0, 0);
    }
    if (kt + 1 < nk) {
      char* nb = lds + ((kt + 1) & 1) * 49152;
#pragma unroll
      for (int i = 0; i < 2; i++) *(uint4*)(nb + soff + i * 8192) = ra[i];
#pragma unroll
      for (int i = 0; i < 4; i++) *(uint4*)(nb + 16384 + soff + i * 8192) = rb[i];
    }
    __syncthreads();
  }
}

__device__ void phase_qkv(const Params& p, char* lds) {
  const int lane = threadIdx.x & 63, wave = threadIdx.x >> 6, wm = wave >> 2, wn = wave & 3, fr = lane & 15, fq = lane >> 4;
  const int nN = QKVD / 256, ntiles = (TOK / 128) * nN;
  for (int t = blockIdx.x; t < ntiles; t += gridDim.x) {
    const int m0 = (t / nN) * 128, n0 = (t % nN) * 256;
    f32x4 acc[4][4];
#pragma unroll
    for (int i = 0; i < 4; i++)
#pragma unroll
      for (int j = 0; j < 4; j++) acc[i][j] = (f32x4){0.f, 0.f, 0.f, 0.f};
    gemm_mainloop(p.xb + (size_t)m0 * DM, DM, p.wt_qkv + (size_t)n0 * DM, DM, DM, lds, acc);
#pragma unroll
    for (int i = 0; i < 4; i++)
#pragma unroll
      for (int j = 0; j < 4; j++) {
        const int n = n0 + wn * 64 + i * 16 + fq * 4, m = m0 + wm * 64 + j * 16 + fr;
        uint2 o;
        o.x = pack2bf(acc[i][j][0], acc[i][j][1]);
        o.y = pack2bf(acc[i][j][2], acc[i][j][3]);
        *(uint2*)(p.qkv + (size_t)m * QKVD + n) = o;
      }
  }
}

template <bool POOL>
__device__ void phase_gemm_resid(const Params& p, char* lds, const u16* A, const u16* Bt, const float* resid,
                                 const float* scale) {
  const int lane = threadIdx.x & 63, wave = threadIdx.x >> 6, wm = wave >> 2, wn = wave & 3, fr = lane & 15, fq = lane >> 4;
  const int nN = DM / 256, ntiles = (TOK / 128) * nN;
  for (int t = blockIdx.x; t < ntiles; t += gridDim.x) {
    const int m0 = (t / nN) * 128, n0 = (t % nN) * 256;
    f32x4 acc[4][4];
#pragma unroll
    for (int i = 0; i < 4; i++)
#pragma unroll
      for (int j = 0; j < 4; j++) acc[i][j] = (f32x4){0.f, 0.f, 0.f, 0.f};
    if (POOL) {
      const int g = n0 >> 9;
      gemm_mainloop(A + (size_t)m0 * DM + g * 512, DM, Bt + (size_t)g * 512 * 512 + (size_t)(n0 - g * 512) * 512, 512, 512,
                    lds, acc);
    } else {
      gemm_mainloop(A + (size_t)m0 * DM, DM, Bt + (size_t)n0 * DM, DM, DM, lds, acc);
    }
#pragma unroll
    for (int i = 0; i < 4; i++)
#pragma unroll
      for (int j = 0; j < 4; j++) {
        const int n = n0 + wn * 64 + i * 16 + fq * 4, m = m0 + wm * 64 + j * 16 + fr;
        const float4 rx = *(const float4*)(resid + (size_t)m * DM + n);
        float4 sc4 = make_float4(1.f, 1.f, 1.f, 1.f);
        if (POOL) sc4 = *(const float4*)(scale + n);
        float4 o;
        o.x = ALPHA * rx.x + acc[i][j][0] * sc4.x;
        o.y = ALPHA * rx.y + acc[i][j][1] * sc4.y;
        o.z = ALPHA * rx.z + acc[i][j][2] * sc4.z;
        o.w = ALPHA * rx.w + acc[i][j][3] * sc4.w;
        *(float4*)(p.y + (size_t)m * DM + n) = o;
      }
  }
}

__device__ void phase_attn(const Params& p, char* lds) {
  const int tid = threadIdx.x, lane = tid & 63, wave = tid >> 6;
  const int r32 = lane & 31, h = lane >> 5;
  char* Kl = lds;
  u16* Vt = (u16*)(lds + 32768);
  for (int it = blockIdx.x; it < 512; it += gridDim.x) {
    const int b = it >> 6, n = (it >> 2) & 15, kvh = it & 3;
    const int tbase = b * 2048 + (n - 1) * 128;
    __syncthreads();
#pragma unroll
    for (int i = 0; i < 4; i++) {
      const int id = tid + NT * i, row = id >> 3, c = id & 7;
      uint4 v = make_uint4(0, 0, 0, 0);
      if (n > 0 || row >= 128) v = *(const uint4*)(p.qkv + (size_t)(tbase + row) * QKVD + 2048 + kvh * 64 + c * 8);
      *(uint4*)(Kl + swz(row, c)) = v;
    }
#pragma unroll
    for (int i = 0; i < 4; i++) {
      const int id = tid + NT * i, key = id & 255, dc = id >> 8;
      uint4 v = make_uint4(0, 0, 0, 0);
      if (n > 0 || key >= 128) v = *(const uint4*)(p.qkv + (size_t)(tbase + key) * QKVD + 2304 + kvh * 64 + dc * 8);
      u16* d = Vt + (dc * 8) * 260 + key;
      d[0 * 260] = (u16)(v.x & 0xFFFF);
      d[1 * 260] = (u16)(v.x >> 16);
      d[2 * 260] = (u16)(v.y & 0xFFFF);
      d[3 * 260] = (u16)(v.y >> 16);
      d[4 * 260] = (u16)(v.z & 0xFFFF);
      d[5 * 260] = (u16)(v.z >> 16);
      d[6 * 260] = (u16)(v.w & 0xFFFF);
      d[7 * 260] = (u16)(v.w >> 16);
    }
    __syncthreads();
    const int hq = kvh * 8 + wave;
    const float slope = exp2f(-0.25f * (float)(hq + 1));
    const float sink = p.sinks[hq];
#pragma unroll 1
    for (int qs = 0; qs < 4; qs++) {
      const size_t tq = (size_t)b * 2048 + n * 128 + qs * 32 + r32;
      bfx8 qf[4];
#pragma unroll
      for (int s = 0; s < 4; s++) qf[s] = *(const bfx8*)(p.qkv + tq * QKVD + hq * 64 + s * 16 + h * 8);
      f32x16 sacc[5];
#pragma unroll
      for (int kt = 0; kt < 5; kt++) {
#pragma unroll
        for (int r = 0; r < 16; r++) sacc[kt][r] = 0.f;
#pragma unroll
        for (int s = 0; s < 4; s++) {
          const bfx8 kf = *(const bfx8*)(Kl + swz(32 * (qs + kt) + r32, 2 * s + h));
          sacc[kt] = __builtin_amdgcn_mfma_f32_32x32x16_bf16(kf, qf[s], sacc[kt], 0, 0, 0);
        }
      }
      float mx = -1e30f;
      float slope_l = slope;
      int dbase = 128 + r32 - 4 * h;
      asm volatile("" : "+v"(slope_l), "+v"(dbase));
#pragma unroll
      for (int kt = 0; kt < 5; kt++)
#pragma unroll
        for (int r = 0; r < 16; r++) {
          const int kj = (r & 3) + 8 * (r >> 2) + 4 * h;
          const int dist = dbase - 32 * kt - ((r & 3) + 8 * (r >> 2));
          const int j = 32 * (qs + kt) + kj;
          const bool valid = (dist >= 0) && (dist < 128) && (n > 0 || j >= 128);
          const float sc = valid ? (sacc[kt][r] * 0.125f - slope_l * (float)dist) : -1e30f;
          sacc[kt][r] = sc;
          mx = fmaxf(mx, sc);
        }
      mx = fmaxf(mx, __shfl_xor(mx, 32));
      mx = fmaxf(mx, sink);
      float sum = 0.f;
#pragma unroll
      for (int kt = 0; kt < 5; kt++)
#pragma unroll
        for (int r = 0; r < 16; r++) {
          const float e = __expf(sacc[kt][r] - mx);
          sacc[kt][r] = e;
          sum += e;
        }
      sum += __shfl_xor(sum, 32);
      const float inv = 1.f / (sum + __expf(sink - mx));
      f32x16 oacc[2];
#pragma unroll
      for (int dt = 0; dt < 2; dt++)
#pragma unroll
        for (int r = 0; r < 16; r++) oacc[dt][r] = 0.f;
#pragma unroll
      for (int kt = 0; kt < 5; kt++)
#pragma unroll
        for (int s2 = 0; s2 < 2; s2++) {
          uint4 pw;
          pw.x = pack2bf(sacc[kt][8 * s2 + 0], sacc[kt][8 * s2 + 1]);
          pw.y = pack2bf(sacc[kt][8 * s2 + 2], sacc[kt][8 * s2 + 3]);
          pw.z = pack2bf(sacc[kt][8 * s2 + 4], sacc[kt][8 * s2 + 5]);
          pw.w = pack2bf(sacc[kt][8 * s2 + 6], sacc[kt][8 * s2 + 7]);
          const bfx8 pf = __builtin_bit_cast(bfx8, pw);
          const int key0 = 32 * (qs + kt) + 16 * s2 + 4 * h;
#pragma unroll
          for (int dt = 0; dt < 2; dt++) {
            const u16* vp = Vt + (dt * 32 + r32) * 260 + key0;
            const uint2 lo = *(const uint2*)vp;
            const uint2 hi = *(const uint2*)(vp + 8);
            const uint4 vw = make_uint4(lo.x, lo.y, hi.x, hi.y);
            oacc[dt] = __builtin_amdgcn_mfma_f32_32x32x16_bf16(__builtin_bit_cast(bfx8, vw), pf, oacc[dt], 0, 0, 0);
          }
        }
#pragma unroll
      for (int dt = 0; dt < 2; dt++)
#pragma unroll
        for (int g4 = 0; g4 < 4; g4++) {
          const int d = dt * 32 + 8 * g4 + 4 * h;
          uint2 o;
          o.x = pack2bf(oacc[dt][4 * g4 + 0] * inv, oacc[dt][4 * g4 + 1] * inv);
          o.y = pack2bf(oacc[dt][4 * g4 + 2] * inv, oacc[dt][4 * g4 + 3] * inv);
          *(uint2*)(p.att + tq * DM + hq * 64 + d) = o;
        }
    }
  }
}

__device__ void phase_ln(const Params& p, const float* g, const float* bta) {
  const int lane = threadIdx.x & 63, wave = threadIdx.x >> 6;
  for (int row = blockIdx.x * 8 + wave; row < TOK; row += gridDim.x * 8) {
    const float* yr = p.y + (size_t)row * DM;
    float4 v[8];
    float s = 0.f;
#pragma unroll
    for (int c = 0; c < 8; c++) {
      v[c] = *(const float4*)(yr + c * 256 + lane * 4);
      s += v[c].x + v[c].y + v[c].z + v[c].w;
    }
#pragma unroll
    for (int o = 32; o > 0; o >>= 1) s += __shfl_xor(s, o);
    const float mu = s * (1.f / DM);
    float q = 0.f;
#pragma unroll
    for (int c = 0; c < 8; c++) {
      v[c].x -= mu; v[c].y -= mu; v[c].z -= mu; v[c].w -= mu;
      q += v[c].x * v[c].x + v[c].y * v[c].y + v[c].z * v[c].z + v[c].w * v[c].w;
    }
#pragma unroll
    for (int o = 32; o > 0; o >>= 1) q += __shfl_xor(q, o);
    const float rstd = rsqrtf(q * (1.f / DM) + LN_EPS);
#pragma unroll
    for (int c = 0; c < 8; c++) {
      const int col = c * 256 + lane * 4;
      const float4 gg = *(const float4*)(g + col), bb = *(const float4*)(bta + col);
      float4 o;
      o.x = v[c].x * rstd * gg.x + bb.x;
      o.y = v[c].y * rstd * gg.y + bb.y;
      o.z = v[c].z * rstd * gg.z + bb.z;
      o.w = v[c].w * rstd * gg.w + bb.w;
      *(float4*)(p.xf + (size_t)row * DM + col) = o;
      uint2 ob;
      ob.x = pack2bf(o.x, o.y);
      ob.y = pack2bf(o.z, o.w);
      *(uint2*)(p.xb + (size_t)row * DM + col) = ob;
    }
  }
}

__device__ void phase_peer_route(const Params& p, char* lds, int layer) {
  const int tid = threadIdx.x, lane = tid & 63, wave = tid >> 6, wm = wave >> 2, wn = wave & 3, fr = lane & 15, fq = lane >> 4;
  const int r32 = lane & 31, h32 = lane >> 5;
  char* ql = lds;
  char* skl = lds + 67584;
  float* keysl = (float*)lds;
  const u16* Wt = p.wt_q + (size_t)layer * 2048 * 2048;
  const int ntiles = (TOK / 128) * 8;
  for (int t = blockIdx.x; t < ntiles; t += gridDim.x) {
    const int m0 = (t >> 3) * 128, hd = t & 7, n0 = hd * 256;
    f32x4 acc[4][4];
#pragma unroll
    for (int i = 0; i < 4; i++)
#pragma unroll
      for (int j = 0; j < 4; j++) acc[i][j] = (f32x4){0.f, 0.f, 0.f, 0.f};
    __syncthreads();
    gemm_mainloop(p.xb + (size_t)m0 * DM, DM, Wt + (size_t)n0 * DM, DM, DM, lds, acc);
#pragma unroll
    for (int i = 0; i < 4; i++)
#pragma unroll
      for (int j = 0; j < 4; j++) {
        const int nl = wn * 64 + i * 16 + fq * 4, ml = wm * 64 + j * 16 + fr;
        uint2 o;
        o.x = pack2bf(acc[i][j][0], acc[i][j][1]);
        o.y = pack2bf(acc[i][j][2], acc[i][j][3]);
        *(uint2*)(ql + ml * 528 + nl * 2) = o;
      }
    {
      const u16* sksrc = p.sk + (size_t)(layer * 8 + hd) * 2 * 128 * 128;
#pragma unroll
      for (int i = 0; i < 8; i++) {
        const int id = tid + NT * i, row = id >> 4, c = id & 15;
        *(uint4*)(skl + row * 272 + c * 16) = *(const uint4*)(sksrc + row * 128 + c * 8);
      }
    }
    __syncthreads();
    const int pp = wave >> 2, tb = wave & 3;
    float L[16];
    {
      f32x16 sacc[4];
#pragma unroll
      for (int kt = 0; kt < 4; kt++)
#pragma unroll
        for (int r = 0; r < 16; r++) sacc[kt][r] = 0.f;
#pragma unroll
      for (int s = 0; s < 8; s++) {
        const bfx8 bq = *(const bfx8*)(ql + (tb * 32 + r32) * 528 + (pp * 128 + s * 16 + h32 * 8) * 2);
#pragma unroll
        for (int kt = 0; kt < 4; kt++) {
          const bfx8 ak = *(const bfx8*)(skl + (pp * 128 + kt * 32 + r32) * 272 + (s * 16 + h32 * 8) * 2);
          sacc[kt] = __builtin_amdgcn_mfma_f32_32x32x16_bf16(ak, bq, sacc[kt], 0, 0, 0);
        }
      }
#pragma unroll
      for (int i = 0; i < 16; i++) L[i] = -INFINITY;
#pragma unroll
      for (int kt = 0; kt < 4; kt++)
#pragma unroll
        for (int r = 0; r < 16; r++) {
          const unsigned key = 32 * kt + (r & 3) + 8 * (r >> 2) + 4 * h32;
          const float xv = __uint_as_float((__float_as_uint(sacc[kt][r]) & ~127u) | key);
          INSERT16(L, xv);
        }
    }
    {
      float O[16];
#pragma unroll
      for (int i = 0; i < 16; i++) O[i] = __shfl_xor(L[i], 32);
#pragma unroll
      for (int i = 0; i < 16; i++) INSERT16(L, O[i]);
    }
    __syncthreads();
    if (h32 == 0) {
#pragma unroll
      for (int i = 0; i < 16; i++) keysl[(tb * 32 + r32) * 33 + pp * 16 + i] = L[i];
    }
    __syncthreads();
    if (tid < 128) {
      float k0[16], k1[16], Bst[16];
#pragma unroll
      for (int i = 0; i < 16; i++) {
        k0[i] = clr7(keysl[tid * 33 + i]);
        k1[i] = clr7(keysl[tid * 33 + 16 + i]);
        Bst[i] = -INFINITY;
      }
#pragma unroll
      for (int i = 0; i < 16; i++)
#pragma unroll
        for (int j = 0; j < 16; j++)
          if ((i + 1) * (j + 1) <= 16) {
            const float v = k0[i] + k1[j];
            const float xv = __uint_as_float((__float_as_uint(v) & ~255u) | (unsigned)(i * 16 + j));
            INSERT16(Bst, xv);
          }
      float bv[16];
      int ei[16];
      float mxv = -INFINITY;
#pragma unroll
      for (int k = 0; k < 16; k++) {
        const unsigned pl = __float_as_uint(Bst[k]) & 255u;
        const float a = keysl[tid * 33 + (pl >> 4)], bq = keysl[tid * 33 + 16 + (pl & 15)];
        bv[k] = clr7(a) + clr7(bq);
        ei[k] = (int)((__float_as_uint(a) & 127u) * 128u + (__float_as_uint(bq) & 127u));
        mxv = fmaxf(mxv, bv[k]);
      }
      float ssum = 0.f;
#pragma unroll
      for (int k = 0; k < 16; k++) {
        bv[k] = __expf(bv[k] - mxv);
        ssum += bv[k];
      }
      const float inv = 1.f / ssum;
      const size_t ob = (size_t)(m0 + tid) * 128 + hd * 16;
#pragma unroll
      for (int k = 0; k < 16; k += 4) {
        *(int4*)(p.pk_idx + ob + k) = make_int4(ei[k], ei[k + 1], ei[k + 2], ei[k + 3]);
        *(float4*)(p.pk_gate + ob + k) = make_float4(bv[k] * inv, bv[k + 1] * inv, bv[k + 2] * inv, bv[k + 3] * inv);
      }
    }
  }
}

__device__ void phase_peer_gather(const Params& p, char* lds, int layer, const float* g, const float* bta, float* outp,
                                  bool write_bf) {
  const int tid = threadIdx.x, lane = tid & 63, half = tid >> 8, ht = tid & 255, hw = (tid >> 6) & 3;
  int* idxl = (int*)lds + half * 128;
  float* gatel = (float*)(lds + 1024) + half * 128;
  float* al = (float*)(lds + 2048) + half * 128;
  float* red = (float*)(lds + 3072) + half * 8;
  const u16* ub = p.ub + (size_t)layer * 16384 * 2048;
  const u16* vb = p.vb + (size_t)layer * 16384 * 2048;
  for (int pr = blockIdx.x; pr < TOK / 2; pr += gridDim.x) {
    const size_t tok = (size_t)pr * 2 + half;
    __syncthreads();
    if (ht < 128) {
      idxl[ht] = p.pk_idx[tok * 128 + ht];
      gatel[ht] = p.pk_gate[tok * 128 + ht];
    }
    uint4 xr[4];
#pragma unroll
    for (int c = 0; c < 4; c++) xr[c] = ((const uint4*)(p.xb + tok * DM))[c * 64 + lane];
    __syncthreads();
    for (int pb = 0; pb < 32; pb += 4) {
      uint4 ur[4][4];
#pragma unroll
      for (int q = 0; q < 4; q++) {
        const int e = idxl[hw * 32 + pb + q];
        const uint4* rp = (const uint4*)(ub + (size_t)e * 2048) + lane;
#pragma unroll
        for (int c = 0; c < 4; c++) ur[q][c] = rp[c * 64];
      }
      float part[4];
#pragma unroll
      for (int q = 0; q < 4; q++) {
        float a = 0.f;
#pragma unroll
        for (int c = 0; c < 4; c++) {
          a = dot2(ur[q][c].x, xr[c].x, a);
          a = dot2(ur[q][c].y, xr[c].y, a);
          a = dot2(ur[q][c].z, xr[c].z, a);
          a = dot2(ur[q][c].w, xr[c].w, a);
        }
#pragma unroll
        for (int o = 32; o > 0; o >>= 1) a += __shfl_xor(a, o);
        part[q] = a;
      }
      if (lane < 4) {
        const float hv = lane == 0 ? part[0] : lane == 1 ? part[1] : lane == 2 ? part[2] : part[3];
        const int pi = hw * 32 + pb + lane;
        al[pi] = gatel[pi] * 0.5f * hv * (1.f + erff(hv * 0.70710678118654752f));
      }
    }
    __syncthreads();
    float f[8];
#pragma unroll
    for (int j = 0; j < 8; j++) f[j] = 0.f;
    for (int pb = 0; pb < 128; pb += 8) {
      uint4 vr[8];
#pragma unroll
      for (int q = 0; q < 8; q++) {
        const int e = idxl[pb + q];
        vr[q] = ((const uint4*)(vb + (size_t)e * 2048))[ht];
      }
#pragma unroll
      for (int q = 0; q < 8; q++) {
        const float a = al[pb + q];
        f[0] += a * bflo(vr[q].x);
        f[1] += a * bfhi(vr[q].x);
        f[2] += a * bflo(vr[q].y);
        f[3] += a * bfhi(vr[q].y);
        f[4] += a * bflo(vr[q].z);
        f[5] += a * bfhi(vr[q].z);
        f[6] += a * bflo(vr[q].w);
        f[7] += a * bfhi(vr[q].w);
      }
    }
    const float4 x0 = *(const float4*)(p.xf + tok * DM + ht * 8), x1 = *(const float4*)(p.xf + tok * DM + ht * 8 + 4);
    f[0] += ALPHA * x0.x; f[1] += ALPHA * x0.y; f[2] += ALPHA * x0.z; f[3] += ALPHA * x0.w;
    f[4] += ALPHA * x1.x; f[5] += ALPHA * x1.y; f[6] += ALPHA * x1.z; f[7] += ALPHA * x1.w;
    float s = 0.f;
#pragma unroll
    for (int j = 0; j < 8; j++) s += f[j];
#pragma unroll
    for (int o = 32; o > 0; o >>= 1) s += __shfl_xor(s, o);
    if (lane == 0) red[hw] = s;
    __syncthreads();
    const float mu = (red[0] + red[1] + red[2] + red[3]) * (1.f / DM);
    float q = 0.f;
#pragma unroll
    for (int j = 0; j < 8; j++) {
      f[j] -= mu;
      q += f[j] * f[j];
    }
#pragma unroll
    for (int o = 32; o > 0; o >>= 1) q += __shfl_xor(q, o);
    if (lane == 0) red[4 + hw] = q;
    __syncthreads();
    const float rstd = rsqrtf((red[4] + red[5] + red[6] + red[7]) * (1.f / DM) + LN_EPS);
    const int col = ht * 8;
    const float4 g0 = *(const float4*)(g + col), g1 = *(const float4*)(g + col + 4);
    const float4 b0 = *(const float4*)(bta + col), b1 = *(const float4*)(bta + col + 4);
    float4 o0, o1;
    o0.x = f[0] * rstd * g0.x + b0.x; o0.y = f[1] * rstd * g0.y + b0.y;
    o0.z = f[2] * rstd * g0.z + b0.z; o0.w = f[3] * rstd * g0.w + b0.w;
    o1.x = f[4] * rstd * g1.x + b1.x; o1.y = f[5] * rstd * g1.y + b1.y;
    o1.z = f[6] * rstd * g1.z + b1.z; o1.w = f[7] * rstd * g1.w + b1.w;
    *(float4*)(outp + tok * DM + col) = o0;
    *(float4*)(outp + tok * DM + col + 4) = o1;
    if (write_bf) {
      uint4 ob;
      ob.x = pack2bf(o0.x, o0.y); ob.y = pack2bf(o0.z, o0.w);
      ob.z = pack2bf(o1.x, o1.y); ob.w = pack2bf(o1.z, o1.w);
      *(uint4*)(p.xb + tok * DM + col) = ob;
    }
  }
}

__device__ void phase_poolmix(const Params& p) {
  for (size_t id = (size_t)blockIdx.x * NT + threadIdx.x; id < (size_t)TOK * 256; id += (size_t)gridDim.x * NT) {
    const int t = (int)(id >> 8), c8 = (int)(id & 255) * 8;
    const int W = 2 << (c8 >> 9), s = t & 2047;
    const int cnt = min(s + 1, W);
    const float* xp = p.xf + (size_t)t * DM + c8;
    const float4 a0 = *(const float4*)xp, a1 = *(const float4*)(xp + 4);
    float4 s0 = a0, s1 = a1;
    for (int r = 1; r < cnt; r++) {
      const float4 b0 = *(const float4*)(xp - (size_t)r * DM), b1 = *(const float4*)(xp - (size_t)r * DM + 4);
      s0.x += b0.x; s0.y += b0.y; s0.z += b0.z; s0.w += b0.w;
      s1.x += b1.x; s1.y += b1.y; s1.z += b1.z; s1.w += b1.w;
    }
    const float ic = 1.f / (float)cnt;
    uint4 o;
    o.x = pack2bf(s0.x * ic - a0.x, s0.y * ic - a0.y);
    o.y = pack2bf(s0.z * ic - a0.z, s0.w * ic - a0.w);
    o.z = pack2bf(s1.x * ic - a1.x, s1.y * ic - a1.y);
    o.w = pack2bf(s1.z * ic - a1.z, s1.w * ic - a1.w);
    *(uint4*)(p.att + (size_t)t * DM + c8) = o;
  }
}

__device__ __forceinline__ void run_phase(const Params& p, char* lds, int ph) {
  switch (ph) {
    case 0: phase_prep(p, lds); break;
    case 1: phase_qkv(p, lds); break;
    case 2: phase_attn(p, lds); break;
    case 3: phase_gemm_resid<false>(p, lds, p.att, p.wt_o, p.x, nullptr); break;
    case 4: phase_ln(p, p.ln_g, p.ln_b); break;
    case 5: phase_peer_route(p, lds, 0); break;
    case 6: phase_peer_gather(p, lds, 0, p.ln_g + DM, p.ln_b + DM, p.xf, true); break;
    case 7: phase_poolmix(p); break;
    case 8: phase_gemm_resid<true>(p, lds, p.att, p.wt_pool, p.xf, p.pool_scale); break;
    case 9: phase_ln(p, p.ln_g + 2 * DM, p.ln_b + 2 * DM); break;
    case 10: phase_peer_route(p, lds, 1); break;
    case 11: phase_peer_gather(p, lds, 1, p.ln_g + 3 * DM, p.ln_b + 3 * DM, p.out, false); break;
  }
}

#if MULTI
template <int PH>
__global__ void __launch_bounds__(NT) phase_kernel(Params p) {
  __shared__ __attribute__((aligned(16))) char lds[LDS_BYTES];
  run_phase(p, lds, PH);
}
#else
__global__ void __launch_bounds__(NT) mega_kernel(Params p) {
  __shared__ __attribute__((aligned(16))) char lds[LDS_BYTES];
  cg::grid_group grid = cg::this_grid();
  for (int ph = 0; ph < NPHASE; ph++) {
    run_phase(p, lds, ph);
    if (ph + 1 < NPHASE) grid.sync();
  }
}
#endif

extern "C" void kernel_launch(void* const* d_in, const int* in_sizes, int n_in, void* d_out, int out_size, void* d_ws,
                              size_t ws_size, hipStream_t stream) {
  Params p{};
  p.x = (const float*)d_in[0];
  p.w_qkv = (const float*)d_in[1];
  p.w_o = (const float*)d_in[2];
  p.sinks = (const float*)d_in[3];
  p.pool_w = (const float*)d_in[4];
  p.pool_scale = (const float*)d_in[5];
  p.ln_g = (const float*)d_in[6];
  p.ln_b = (const float*)d_in[7];
  p.wq = (const float*)d_in[8];
  p.subkeys = (const float*)d_in[9];
  p.pu = (const float*)d_in[10];
  p.pv = (const float*)d_in[11];
  p.out = (float*)d_out;
  char* w = (char*)d_ws;
  size_t off = 0;
  auto take = [&](size_t bytes) {
    char* r = w + off;
    off += (bytes + 255) & ~(size_t)255;
    return r;
  };
  p.wt_qkv = (u16*)take((size_t)2560 * 2048 * 2);
  p.wt_o = (u16*)take((size_t)2048 * 2048 * 2);
  p.wt_pool = (u16*)take((size_t)4 * 512 * 512 * 2);
  p.wt_q = (u16*)take((size_t)2 * 2048 * 2048 * 2);
  p.sk = (u16*)take((size_t)2 * 8 * 2 * 128 * 128 * 2);
  p.ub = (u16*)take((size_t)2 * 16384 * 2048 * 2);
  p.vb = (u16*)take((size_t)2 * 16384 * 2048 * 2);
  p.xb = (u16*)take((size_t)TOK * DM * 2);
  p.qkv = (u16*)take((size_t)TOK * QKVD * 2);
  p.att = (u16*)take((size_t)TOK * DM * 2);
  p.xf = (float*)take((size_t)TOK * DM * 4);
  p.y = (float*)take((size_t)TOK * DM * 4);
  p.pk_idx = (int*)take((size_t)TOK * 128 * 4);
  p.pk_gate = (float*)take((size_t)TOK * 128 * 4);
  if (off > ws_size) {
    fprintf(stderr, "workspace too small: need %zu have %zu\n", off, ws_size);
    return;
  }
#if MULTI
  const int grid = 256;
  phase_kernel<0><<<grid, NT, 0, stream>>>(p);
  phase_kernel<1><<<grid, NT, 0, stream>>>(p);
  phase_kernel<2><<<grid, NT, 0, stream>>>(p);
  phase_kernel<3><<<grid, NT, 0, stream>>>(p);
  phase_kernel<4><<<grid, NT, 0, stream>>>(p);
  phase_kernel<5><<<grid, NT, 0, stream>>>(p);
  phase_kernel<6><<<grid, NT, 0, stream>>>(p);
  phase_kernel<7><<<grid, NT, 0, stream>>>(p);
  phase_kernel<8><<<grid, NT, 0, stream>>>(p);
  phase_kernel<9><<<grid, NT, 0, stream>>>(p);
  phase_kernel<10><<<grid, NT, 0, stream>>>(p);
  phase_kernel<11><<<grid, NT, 0, stream>>>(p);
#else
  static int grid_blocks = 0;
  if (!grid_blocks) {
    int dev = 0, cus = 0, per_cu = 0;
    hipGetDevice(&dev);
    hipDeviceGetAttribute(&cus, hipDeviceAttributeMultiprocessorCount, dev);
    hipOccupancyMaxActiveBlocksPerMultiprocessor(&per_cu, mega_kernel, NT, 0);
    if (per_cu > 1) per_cu = 1;
    grid_blocks = cus * per_cu;
  }
  void* args[] = {&p};
  hipError_t e = hipLaunchCooperativeKernel((void*)mega_kernel, dim3(grid_blocks), dim3(NT), args, 0, stream);
  if (e != hipSuccess) fprintf(stderr, "cooperative launch failed: %s (grid %d)\n", hipGetErrorString(e), grid_blocks);
#endif
}
```

```cpp
#include <hip/hip_runtime.h>
#include <hip/hip_cooperative_groups.h>
#include <cstdio>
namespace cg = cooperative_groups;

#ifndef MULTI
#define MULTI 0
#endif

typedef unsigned short u16;
using bfx8 = __attribute__((ext_vector_type(8))) __bf16;
using bfx2 = __attribute__((ext_vector_type(2))) __bf16;
using f32x4 = __attribute__((ext_vector_type(4))) float;
using f32x16 = __attribute__((ext_vector_type(16))) float;
typedef float f32x2 __attribute__((ext_vector_type(2)));

constexpr int NT = 512;
constexpr int TOK = 16384, DM = 2048, QKVD = 2560;
constexpr int LDX = 2112, LDP = 576;
constexpr float ALPHA = 1.41421356237309515f;
constexpr float LN_EPS = 1e-5f;
constexpr int LDS_BYTES = 147456;
constexpr int NPHASE = 18;

struct Params {
  const float *x, *w_qkv, *w_o, *sinks, *pool_w, *pool_scale, *ln_g, *ln_b, *wq, *subkeys, *pu, *pv;
  float* out;
  u16 *wt_qkv, *wt_o, *wt_pool, *wt_q, *sk, *xb, *qkv, *att;
  unsigned char *ub8, *vb8;
  u16* yb;
  float *pk_gate, *uinv, *vinv;
  u16* pk_idx;
  unsigned *bar, *xbar;
  u16* hpart;
  float* act;
};

__device__ __forceinline__ int otid() {
  int t = threadIdx.x;
  asm volatile("" : "+v"(t));
  return t;
}
__device__ __forceinline__ u16 f2bf(float f) {
  unsigned u = __float_as_uint(f);
  u += 0x7FFFu + ((u >> 16) & 1u);
  return (u16)(u >> 16);
}
__device__ __forceinline__ unsigned pack2bf(float a, float b) {
  return (unsigned)f2bf(a) | ((unsigned)f2bf(b) << 16);
}
__device__ __forceinline__ float bflo(unsigned w) { return __uint_as_float(w << 16); }
__device__ __forceinline__ float bfhi(unsigned w) { return __uint_as_float(w & 0xFFFF0000u); }
__device__ __forceinline__ float dot2(unsigned a, unsigned b, float c) {
  return __builtin_amdgcn_fdot2_f32_bf16(__builtin_bit_cast(bfx2, a), __builtin_bit_cast(bfx2, b), c, false);
}
__device__ __forceinline__ float clr7(float v) { return __uint_as_float(__float_as_uint(v) & ~127u); }

#define INSERT16(L, xx)                              \
  {                                                  \
    float _x = (xx);                                 \
    _Pragma("unroll") for (int _i = 0; _i < 16; _i++) { \
      float _h = fmaxf(L[_i], _x);                   \
      _x = fminf(L[_i], _x);                         \
      L[_i] = _h;                                    \
    }                                                \
  }

__device__ __forceinline__ void sort16_desc(float (&v)[16]) {
#pragma unroll
  for (int k = 2; k <= 16; k <<= 1)
#pragma unroll
    for (int j = k >> 1; j > 0; j >>= 1)
#pragma unroll
      for (int i = 0; i < 16; i++) {
        const int l = i ^ j;
        if (l > i) {
          const bool desc = ((i & k) == 0);
          const float a = v[i], b = v[l];
          v[i] = desc ? fmaxf(a, b) : fminf(a, b);
          v[l] = desc ? fminf(a, b) : fmaxf(a, b);
        }
      }
}
__device__ __forceinline__ void merge16_desc(float (&a)[16], const float (&b)[16]) {
#pragma unroll
  for (int i = 0; i < 16; i++) a[i] = fmaxf(a[i], b[15 - i]);
#pragma unroll
  for (int j = 8; j > 0; j >>= 1)
#pragma unroll
    for (int i = 0; i < 16; i++) {
      const int l = i ^ j;
      if (l > i) {
        const float x = a[i], y = a[l];
        a[i] = fmaxf(x, y);
        a[l] = fminf(x, y);
      }
    }
}

__device__ void transpose_cvt(const float* __restrict__ src, u16* __restrict__ dst, int K, int N, int ldd, float* tile) {
  const int tilesN = N / 64, nt = tilesN * (K / 64);
  const int tid = otid();
  for (int t = blockIdx.x; t < nt; t += gridDim.x) {
    const int k0 = (t / tilesN) * 64, n0 = (t % tilesN) * 64;
    __syncthreads();
#pragma unroll
    for (int i = 0; i < 2; i++) {
      const int r = (tid >> 4) + i * 32, c4 = (tid & 15) * 4;
      const float4 v = *(const float4*)(src + (size_t)(k0 + r) * N + n0 + c4);
      tile[r * 65 + c4 + 0] = v.x;
      tile[r * 65 + c4 + 1] = v.y;
      tile[r * 65 + c4 + 2] = v.z;
      tile[r * 65 + c4 + 3] = v.w;
    }
    __syncthreads();
    const int n = tid >> 3, kc = (tid & 7) * 8;
    uint4 o;
    o.x = pack2bf(tile[(kc + 0) * 65 + n], tile[(kc + 1) * 65 + n]);
    o.y = pack2bf(tile[(kc + 2) * 65 + n], tile[(kc + 3) * 65 + n]);
    o.z = pack2bf(tile[(kc + 4) * 65 + n], tile[(kc + 5) * 65 + n]);
    o.w = pack2bf(tile[(kc + 6) * 65 + n], tile[(kc + 7) * 65 + n]);
    *(uint4*)(dst + (size_t)(n0 + n) * ldd + k0 + kc) = o;
  }
}

__device__ void cvt_bf16(const float* __restrict__ src, u16* __restrict__ dst, size_t n) {
  const size_t nch = n / 8;
  for (size_t i = (size_t)blockIdx.x * NT + otid(); i < nch; i += (size_t)gridDim.x * NT) {
    const float4 a = ((const float4*)src)[2 * i], b = ((const float4*)src)[2 * i + 1];
    uint4 o;
    o.x = pack2bf(a.x, a.y);
    o.y = pack2bf(a.z, a.w);
    o.z = pack2bf(b.x, b.y);
    o.w = pack2bf(b.z, b.w);
    ((uint4*)dst)[i] = o;
  }
}

__device__ void cvt_fp8_rows(const float* __restrict__ src, unsigned char* __restrict__ dst, float* __restrict__ inv,
                             int nrows) {
  const int tidq = otid(), lane = tidq & 63, wave = tidq >> 6;
  for (int row = blockIdx.x * 8 + wave; row < nrows; row += gridDim.x * 8) {
    const float* sr = src + (size_t)row * 2048;
    float4 v[8];
    float mx = 0.f;
#pragma unroll
    for (int c = 0; c < 8; c++) {
      v[c] = *(const float4*)(sr + c * 256 + lane * 4);
      mx = fmaxf(mx, fmaxf(fmaxf(fabsf(v[c].x), fabsf(v[c].y)), fmaxf(fabsf(v[c].z), fabsf(v[c].w))));
    }
#pragma unroll
    for (int o = 32; o > 0; o >>= 1) mx = fmaxf(mx, __shfl_xor(mx, o));
    const float sc = mx > 0.f ? 448.f / mx : 1.f;
    if (lane == 0) inv[row] = mx > 0.f ? mx * (1.f / 448.f) : 1.f;
#pragma unroll
    for (int c = 0; c < 8; c++) {
      int pk = 0;
      pk = __builtin_amdgcn_cvt_pk_fp8_f32(v[c].x * sc, v[c].y * sc, pk, false);
      pk = __builtin_amdgcn_cvt_pk_fp8_f32(v[c].z * sc, v[c].w * sc, pk, true);
      const int lay = row >> 14, er = row & 16383, sl = 2 * c + (lane >> 5);
      *(int*)(dst + (size_t)lay * (16384 * 2048) + (size_t)sl * (16384 * 128) + (size_t)er * 128 + (lane & 31) * 4) = pk;
    }
  }
}

__device__ void cvt_bf16_rows(const float* __restrict__ src, u16* __restrict__ dst, int nrows) {
  const size_t nch = (size_t)nrows * 256;
  for (size_t i = (size_t)blockIdx.x * NT + otid(); i < nch; i += (size_t)gridDim.x * NT) {
    const size_t row = i >> 8;
    const int c8 = (int)(i & 255) * 8;
    const float4 a = *(const float4*)(src + row * DM + c8), b = *(const float4*)(src + row * DM + c8 + 4);
    uint4 o;
    o.x = pack2bf(a.x, a.y);
    o.y = pack2bf(a.z, a.w);
    o.z = pack2bf(b.x, b.y);
    o.w = pack2bf(b.z, b.w);
    *(uint4*)(dst + row * LDX + c8) = o;
  }
}

__device__ void phase_prep(const Params& p, char* lds) {
  float* tile = (float*)lds;
  transpose_cvt(p.w_qkv, p.wt_qkv, 2048, 2560, LDX, tile);
  transpose_cvt(p.w_o, p.wt_o, 2048, 2048, LDX, tile);
  for (int g = 0; g < 4; g++) transpose_cvt(p.pool_w + (size_t)g * 512 * 512, p.wt_pool + (size_t)g * 512 * LDP, 512, 512, LDP, tile);
  for (int l = 0; l < 2; l++) transpose_cvt(p.wq + (size_t)l * 2048 * 2048, p.wt_q + (size_t)l * 2048 * LDX, 2048, 2048, LDX, tile);
  cvt_bf16(p.subkeys, p.sk, (size_t)2 * 8 * 2 * 128 * 128);
  cvt_bf16_rows(p.x, p.xb, TOK);
  cvt_fp8_rows(p.pu, p.ub8, p.uinv, 2 * 16384);
  cvt_fp8_rows(p.pv, p.vb8, p.vinv, 2 * 16384);
}

__device__ __forceinline__ int swz(int row, int c) { return row * 128 + ((c ^ ((row >> 1) & 7)) << 4); }

__device__ __forceinline__ void dma16(const u16* g, char* l) {
  __builtin_amdgcn_global_load_lds((const unsigned*)g, (unsigned*)l, 16, 0, 0);
}
__device__ __forceinline__ void dma16u(const u16* gbase, unsigned voff, char* l) {
  __builtin_amdgcn_global_load_lds((const unsigned*)((const char*)gbase + voff), (unsigned*)l, 16, 0, 0);
}

__device__ __forceinline__ void gemm_mainloop(const u16* __restrict__ A, int lda, const u16* __restrict__ B, int ldb,
                                              int K, char* lds, f32x4 (&acc)[4][4]) {
  const int tid = otid(), lane = tid & 63, wave = tid >> 6;
  const int wm = wave >> 2, wn = wave & 3;
  const int fr = lane & 15, fq = lane >> 4;
  const int srow = tid >> 3, sp = tid & 7;
  const int sc = sp ^ ((srow >> 1) & 7);
  const unsigned va = (unsigned)(srow * lda + sc * 8) * 2u, vb = (unsigned)(srow * ldb + sc * 8) * 2u;
  const int soff = tid * 16;
  const int nk = K >> 6;
  const size_t sa = (size_t)64 * lda, sb = (size_t)64 * ldb;
#define GEMM_ISSUE(KT, STG)                                   \
  {                                                           \
    const int kn_ = (KT) * 64;                                \
    char* nb_ = lds + (STG) * 49152;                          \
    dma16u(A + kn_, va, nb_ + soff);                          \
    dma16u(A + sa + kn_, va, nb_ + soff + 8192);              \
    dma16u(B + kn_, vb, nb_ + 16384 + soff);                  \
    dma16u(B + sb + kn_, vb, nb_ + 16384 + soff + 8192);      \
    dma16u(B + 2 * sb + kn_, vb, nb_ + 16384 + soff + 16384); \
    dma16u(B + 3 * sb + kn_, vb, nb_ + 16384 + soff + 24576); \
  }
  GEMM_ISSUE(0, 0);
  GEMM_ISSUE(1, 1);
  int stg = 0;
  for (int kt = 0; kt < nk; kt++) {
    if (kt + 1 < nk) asm volatile("s_waitcnt vmcnt(6)" ::: "memory");
    else asm volatile("s_waitcnt vmcnt(0)" ::: "memory");
    asm volatile("s_waitcnt lgkmcnt(0)" ::: "memory");
    __builtin_amdgcn_s_barrier();
    const char* ab = lds + stg * 49152;
    const char* bb = ab + 16384;
#pragma unroll
    for (int ks = 0; ks < 2; ks++) {
      const int co = ((ks * 4 + fq) ^ ((fr >> 1) & 7)) << 4;
      bfx8 wf[4], xf[4];
#pragma unroll
      for (int i = 0; i < 4; i++) wf[i] = *(const bfx8*)(bb + (wn * 64 + i * 16 + fr) * 128 + co);
#pragma unroll
      for (int j = 0; j < 4; j++) xf[j] = *(const bfx8*)(ab + (wm * 64 + j * 16 + fr) * 128 + co);
      if (ks == 0 && kt + 2 < nk) {
        const int st2 = stg >= 1 ? stg - 1 : 2;
        GEMM_ISSUE(kt + 2, st2);
      }
#pragma unroll
      for (int i = 0; i < 4; i++)
#pragma unroll
        for (int j = 0; j < 4; j++) acc[i][j] = __builtin_amdgcn_mfma_f32_16x16x32_bf16(wf[i], xf[j], acc[i][j], 0, 0, 0);
    }
    stg = stg == 2 ? 0 : stg + 1;
  }
#undef GEMM_ISSUE
  asm volatile("s_waitcnt lgkmcnt(0)" ::: "memory");
  __syncthreads();
}

__device__ __forceinline__ void gemm_mainloop256(const u16* __restrict__ A, int lda, const u16* __restrict__ B, int ldb,
                                                 int K, char* lds, f32x4 (&acc)[4][8]) {
  const int tid = otid(), lane = tid & 63, wave = tid >> 6;
  const int wm = wave >> 2, wn = wave & 3;
  const int fr = lane & 15, fq = lane >> 4;
  const int srow = tid >> 3, sp = tid & 7;
  const int sc = sp ^ ((srow >> 1) & 7);
  const unsigned va = (unsigned)(srow * lda + sc * 8) * 2u, vb = (unsigned)(srow * ldb + sc * 8) * 2u;
  const int soff = tid * 16;
  const int nk = K >> 6;
  const size_t sa = (size_t)64 * lda, sb = (size_t)64 * ldb;
#define GEMM_ISSUE2(KT, STG)                                  \
  {                                                           \
    const int kn_ = (KT) * 64;                                \
    char* nb_ = lds + (STG) * 65536;                          \
    dma16u(A + kn_, va, nb_ + soff);                          \
    dma16u(A + sa + kn_, va, nb_ + soff + 8192);              \
    dma16u(A + 2 * sa + kn_, va, nb_ + soff + 16384);         \
    dma16u(A + 3 * sa + kn_, va, nb_ + soff + 24576);         \
    dma16u(B + kn_, vb, nb_ + 32768 + soff);                  \
    dma16u(B + sb + kn_, vb, nb_ + 32768 + soff + 8192);      \
    dma16u(B + 2 * sb + kn_, vb, nb_ + 32768 + soff + 16384); \
    dma16u(B + 3 * sb + kn_, vb, nb_ + 32768 + soff + 24576); \
  }
  GEMM_ISSUE2(0, 0);
  for (int kt = 0; kt < nk; kt++) {
    asm volatile("s_waitcnt vmcnt(0)" ::: "memory");
    asm volatile("s_waitcnt lgkmcnt(0)" ::: "memory");
    __builtin_amdgcn_s_barrier();
    if (kt + 1 < nk) GEMM_ISSUE2(kt + 1, (kt + 1) & 1);
    const char* ab = lds + (kt & 1) * 65536;
    const char* bb = ab + 32768;
#pragma unroll
    for (int ks = 0; ks < 2; ks++) {
      const int co = ((ks * 4 + fq) ^ ((fr >> 1) & 7)) << 4;
      bfx8 wf[4];
#pragma unroll
      for (int i = 0; i < 4; i++) wf[i] = *(const bfx8*)(bb + (wn * 64 + i * 16 + fr) * 128 + co);
#pragma unroll
      for (int jj = 0; jj < 8; jj += 4) {
        bfx8 xf[4];
#pragma unroll
        for (int j = 0; j < 4; j++) xf[j] = *(const bfx8*)(ab + (wm * 128 + (jj + j) * 16 + fr) * 128 + co);
#pragma unroll
        for (int i = 0; i < 4; i++)
#pragma unroll
          for (int j = 0; j < 4; j++)
            acc[i][jj + j] = __builtin_amdgcn_mfma_f32_16x16x32_bf16(wf[i], xf[j], acc[i][jj + j], 0, 0, 0);
      }
    }
  }
#undef GEMM_ISSUE2
  asm volatile("s_waitcnt lgkmcnt(0)" ::: "memory");
  __syncthreads();
}

__device__ __forceinline__ bool tile_map(int it, int nM, int nN, int& mt, int& nt) {
  const int xcd = blockIdx.x & 7, local = blockIdx.x >> 3, nlocal = gridDim.x >> 3;
  const int per = (nM >> 3) * nN;
  const int idx = it * nlocal + local;
  if (idx >= per) return false;
  mt = xcd * (nM >> 3) + idx / nN;
  nt = idx % nN;
  return true;
}

__device__ void phase_qkv(const Params& p, char* lds) {
  const int nN = QKVD / 256;
  for (int it = 0;; it++) {
    int mt, nt;
    if (!tile_map(it, TOK / 128, nN, mt, nt)) break;
    const int m0 = mt * 128, n0 = nt * 256;
    f32x4 acc[4][4];
#pragma unroll
    for (int i = 0; i < 4; i++)
#pragma unroll
      for (int j = 0; j < 4; j++) acc[i][j] = (f32x4){0.f, 0.f, 0.f, 0.f};
    gemm_mainloop(p.xb + (size_t)m0 * LDX, LDX, p.wt_qkv + (size_t)n0 * LDX, LDX, DM, lds, acc);
    {
      const int tid = otid(), lane = tid & 63, wave = tid >> 6, wm = wave >> 2, wn = wave & 3, fr = lane & 15, fq = lane >> 4;
#pragma unroll
      for (int i = 0; i < 4; i++)
#pragma unroll
        for (int j = 0; j < 4; j++) {
          uint2 o;
          o.x = pack2bf(acc[i][j][0], acc[i][j][1]);
          o.y = pack2bf(acc[i][j][2], acc[i][j][3]);
          *(uint2*)(lds + (wm * 64 + j * 16 + fr) * 528 + (wn * 64 + i * 16 + fq * 4) * 2) = o;
        }
      __syncthreads();
#pragma unroll
      for (int rr = 0; rr < 8; rr++) {
        const int row = wave * 16 + rr * 2 + (lane >> 5), c8 = (lane & 31) * 8;
        const uint4 v = *(const uint4*)(lds + row * 528 + c8 * 2);
        *(uint4*)(p.qkv + (size_t)(m0 + row) * QKVD + n0 + c8) = v;
      }
      __syncthreads();
    }
  }
}

template <bool POOL>
__device__ void phase_gemm_resid(const Params& p, char* lds, const u16* A, const u16* Bt, const float* resid,
                                 const float* scale) {
  const int nN = DM / 256;
  for (int it = 0;; it++) {
    int mt, nt;
    if (!tile_map(it, TOK / 256, nN, mt, nt)) break;
    const int m0 = mt * 256, n0 = nt * 256;
    f32x4 acc[4][8];
#pragma unroll
    for (int i = 0; i < 4; i++)
#pragma unroll
      for (int j = 0; j < 8; j++) acc[i][j] = (f32x4){0.f, 0.f, 0.f, 0.f};
    if (POOL) {
      const int g = n0 >> 9;
      gemm_mainloop256(A + (size_t)m0 * LDX + g * 512, LDX, Bt + (size_t)g * 512 * LDP + (size_t)(n0 - g * 512) * LDP, LDP, 512,
                       lds, acc);
    } else {
      gemm_mainloop256(A + (size_t)m0 * LDX, LDX, Bt + (size_t)n0 * LDX, LDX, DM, lds, acc);
    }
    {
      const int tid = otid(), lane = tid & 63, wave = tid >> 6, wm = wave >> 2, wn = wave & 3, fr = lane & 15, fq = lane >> 4;
      const int c8 = (lane & 31) * 8, nb = n0 + c8;
      float4 sa4 = make_float4(1.f, 1.f, 1.f, 1.f), sb4 = sa4;
      if (POOL) {
        sa4 = *(const float4*)(scale + nb);
        sb4 = *(const float4*)(scale + nb + 4);
      }
#pragma unroll
      for (int half = 0; half < 2; half++) {
        if (wm == half) {
#pragma unroll
          for (int i = 0; i < 4; i++)
#pragma unroll
            for (int j = 0; j < 8; j++)
              *(float4*)(lds + ((j * 16 + fr) * 264 + wn * 64 + i * 16 + fq * 4) * 4) =
                  make_float4(acc[i][j][0], acc[i][j][1], acc[i][j][2], acc[i][j][3]);
        }
        __syncthreads();
        float4 ra[8], rb[8];
#pragma unroll
        for (int rr = 0; rr < 8; rr++) {
          const size_t m = (size_t)(m0 + half * 128 + wave * 16 + rr * 2 + (lane >> 5));
          if (true) {
            const uint4 w4 = *(const uint4*)(p.xb + m * LDX + nb);
            ra[rr] = make_float4(bflo(w4.x), bfhi(w4.x), bflo(w4.y), bfhi(w4.y));
            rb[rr] = make_float4(bflo(w4.z), bfhi(w4.z), bflo(w4.w), bfhi(w4.w));
          } else {
            ra[rr] = *(const float4*)(resid + m * DM + nb);
            rb[rr] = *(const float4*)(resid + m * DM + nb + 4);
          }
        }
#pragma unroll
        for (int rr = 0; rr < 8; rr++) {
          const int row = wave * 16 + rr * 2 + (lane >> 5);
          const float4 va = *(const float4*)(lds + (row * 264 + c8) * 4), vb = *(const float4*)(lds + (row * 264 + c8 + 4) * 4);
          uint4 o;
          o.x = pack2bf(ALPHA * ra[rr].x + va.x * sa4.x, ALPHA * ra[rr].y + va.y * sa4.y);
          o.y = pack2bf(ALPHA * ra[rr].z + va.z * sa4.z, ALPHA * ra[rr].w + va.w * sa4.w);
          o.z = pack2bf(ALPHA * rb[rr].x + vb.x * sb4.x, ALPHA * rb[rr].y + vb.y * sb4.y);
          o.w = pack2bf(ALPHA * rb[rr].z + vb.z * sb4.z, ALPHA * rb[rr].w + vb.w * sb4.w);
          *(uint4*)(p.yb + (size_t)(m0 + half * 128 + row) * DM + nb) = o;
        }
        __syncthreads();
      }
    }
  }
}

__device__ void phase_attn(const Params& p, char* lds) {
  const int tid = otid(), lane = tid & 63, wave = tid >> 6;
  const int r32 = lane & 31, h = lane >> 5;
  char* Kl = lds;
  u16* Vt = (u16*)(lds + 32768);
  for (int it = blockIdx.x; it < 512; it += gridDim.x) {
    const int b = it >> 6, n = (it >> 2) & 15, kvh = it & 3;
    const int tbase = b * 2048 + (n - 1) * 128;
    __syncthreads();
#pragma unroll
    for (int i = 0; i < 4; i++) {
      const int id = tid + NT * i, row = id >> 3, c = id & 7;
      uint4 v = make_uint4(0, 0, 0, 0);
      if (n > 0 || row >= 128) v = *(const uint4*)(p.qkv + (size_t)(tbase + row) * QKVD + 2048 + kvh * 64 + c * 8);
      *(uint4*)(Kl + swz(row, c)) = v;
    }
#pragma unroll
    for (int i = 0; i < 4; i++) {
      const int id = tid + NT * i, key = id & 255, dc = id >> 8;
      uint4 v = make_uint4(0, 0, 0, 0);
      if (n > 0 || key >= 128) v = *(const uint4*)(p.qkv + (size_t)(tbase + key) * QKVD + 2304 + kvh * 64 + dc * 8);
      u16* d = Vt + (dc * 8) * 260 + key;
      d[0 * 260] = (u16)(v.x & 0xFFFF);
      d[1 * 260] = (u16)(v.x >> 16);
      d[2 * 260] = (u16)(v.y & 0xFFFF);
      d[3 * 260] = (u16)(v.y >> 16);
      d[4 * 260] = (u16)(v.z & 0xFFFF);
      d[5 * 260] = (u16)(v.z >> 16);
      d[6 * 260] = (u16)(v.w & 0xFFFF);
      d[7 * 260] = (u16)(v.w >> 16);
    }
    __syncthreads();
    const int hq = kvh * 8 + wave;
    const float slope = exp2f(-0.25f * (float)(hq + 1));
    const float sink = p.sinks[hq];
    bfx8 qn[4];
    {
      const size_t tq0 = (size_t)b * 2048 + n * 128 + r32;
#pragma unroll
      for (int s = 0; s < 4; s++) qn[s] = *(const bfx8*)(p.qkv + tq0 * QKVD + hq * 64 + s * 16 + h * 8);
    }
#pragma unroll 1
    for (int qs = 0; qs < 4; qs++) {
      const size_t tq = (size_t)b * 2048 + n * 128 + qs * 32 + r32;
      bfx8 qf[4];
#pragma unroll
      for (int s = 0; s < 4; s++) qf[s] = qn[s];
      {
        const size_t tqn = (size_t)b * 2048 + n * 128 + (qs < 3 ? qs + 1 : 3) * 32 + r32;
#pragma unroll
        for (int s = 0; s < 4; s++) qn[s] = *(const bfx8*)(p.qkv + tqn * QKVD + hq * 64 + s * 16 + h * 8);
      }
      f32x16 sacc[5];
#pragma unroll
      for (int kt = 0; kt < 5; kt++) {
#pragma unroll
        for (int r = 0; r < 16; r++) sacc[kt][r] = 0.f;
#pragma unroll
        for (int s = 0; s < 4; s++) {
          const bfx8 kf = *(const bfx8*)(Kl + swz(32 * (qs + kt) + r32, 2 * s + h));
          sacc[kt] = __builtin_amdgcn_mfma_f32_32x32x16_bf16(kf, qf[s], sacc[kt], 0, 0, 0);
        }
      }
      float mx = -1e30f;
      float slope_l = slope;
      int dbase = 128 + r32 - 4 * h;
      asm volatile("" : "+v"(slope_l), "+v"(dbase));
#pragma unroll
      for (int kt = 0; kt < 5; kt++)
#pragma unroll
        for (int r = 0; r < 16; r++) {
          const int kj = (r & 3) + 8 * (r >> 2) + 4 * h;
          const int dist = dbase - 32 * kt - ((r & 3) + 8 * (r >> 2));
          const int j = 32 * (qs + kt) + kj;
          const bool valid = (dist >= 0) && (dist < 128) && (n > 0 || j >= 128);
          const float sc = valid ? (sacc[kt][r] * 0.125f - slope_l * (float)dist) : -1e30f;
          sacc[kt][r] = sc;
          mx = fmaxf(mx, sc);
        }
      mx = fmaxf(mx, __shfl_xor(mx, 32));
      mx = fmaxf(mx, sink);
      float sum = 0.f;
#pragma unroll
      for (int kt = 0; kt < 5; kt++)
#pragma unroll
        for (int r = 0; r < 16; r++) {
          const float e = __expf(sacc[kt][r] - mx);
          sacc[kt][r] = e;
          sum += e;
        }
      sum += __shfl_xor(sum, 32);
      const float inv = 1.f / (sum + __expf(sink - mx));
      f32x16 oacc[2];
#pragma unroll
      for (int dt = 0; dt < 2; dt++)
#pragma unroll
        for (int r = 0; r < 16; r++) oacc[dt][r] = 0.f;
#pragma unroll
      for (int kt = 0; kt < 5; kt++)
#pragma unroll
        for (int s2 = 0; s2 < 2; s2++) {
          uint4 pw;
          pw.x = pack2bf(sacc[kt][8 * s2 + 0], sacc[kt][8 * s2 + 1]);
          pw.y = pack2bf(sacc[kt][8 * s2 + 2], sacc[kt][8 * s2 + 3]);
          pw.z = pack2bf(sacc[kt][8 * s2 + 4], sacc[kt][8 * s2 + 5]);
          pw.w = pack2bf(sacc[kt][8 * s2 + 6], sacc[kt][8 * s2 + 7]);
          const bfx8 pf = __builtin_bit_cast(bfx8, pw);
          const int key0 = 32 * (qs + kt) + 16 * s2 + 4 * h;
#pragma unroll
          for (int dt = 0; dt < 2; dt++) {
            const u16* vp = Vt + (dt * 32 + r32) * 260 + key0;
            const uint2 lo = *(const uint2*)vp;
            const uint2 hi = *(const uint2*)(vp + 8);
            const uint4 vw = make_uint4(lo.x, lo.y, hi.x, hi.y);
            oacc[dt] = __builtin_amdgcn_mfma_f32_32x32x16_bf16(__builtin_bit_cast(bfx8, vw), pf, oacc[dt], 0, 0, 0);
          }
        }
#pragma unroll
      for (int dt = 0; dt < 2; dt++)
#pragma unroll
        for (int g4 = 0; g4 < 4; g4++) {
          const int d = dt * 32 + 8 * g4 + 4 * h;
          uint2 o;
          o.x = pack2bf(oacc[dt][4 * g4 + 0] * inv, oacc[dt][4 * g4 + 1] * inv);
          o.y = pack2bf(oacc[dt][4 * g4 + 2] * inv, oacc[dt][4 * g4 + 3] * inv);
          *(uint2*)(p.att + tq * LDX + hq * 64 + d) = o;
        }
    }
  }
}

__device__ void phase_ln(const Params& p, const float* g, const float* bta, float* outf, bool write_bf) {
  const int tidq = otid(), lane = tidq & 63, wave = tidq >> 6;
  const int stride = gridDim.x * 8;
  int row = blockIdx.x * 8 + wave;
  uint4 w[4], wn[4];
#pragma unroll
  for (int c = 0; c < 4; c++) w[c] = *(const uint4*)(p.yb + (size_t)row * DM + c * 512 + lane * 8);
  while (row < TOK) {
    const int nrow = row + stride;
    const int lrow = nrow < TOK ? nrow : row;
#pragma unroll
    for (int c = 0; c < 4; c++) wn[c] = *(const uint4*)(p.yb + (size_t)lrow * DM + c * 512 + lane * 8);
    float v[32];
#pragma unroll
    for (int c = 0; c < 4; c++) {
      v[c * 8 + 0] = bflo(w[c].x); v[c * 8 + 1] = bfhi(w[c].x);
      v[c * 8 + 2] = bflo(w[c].y); v[c * 8 + 3] = bfhi(w[c].y);
      v[c * 8 + 4] = bflo(w[c].z); v[c * 8 + 5] = bfhi(w[c].z);
      v[c * 8 + 6] = bflo(w[c].w); v[c * 8 + 7] = bfhi(w[c].w);
    }
    float s = 0.f;
#pragma unroll
    for (int j = 0; j < 32; j++) s += v[j];
#pragma unroll
    for (int o = 32; o > 0; o >>= 1) s += __shfl_xor(s, o);
    const float mu = s * (1.f / DM);
    float q = 0.f;
#pragma unroll
    for (int j = 0; j < 32; j++) {
      v[j] -= mu;
      q += v[j] * v[j];
    }
#pragma unroll
    for (int o = 32; o > 0; o >>= 1) q += __shfl_xor(q, o);
    const float rstd = rsqrtf(q * (1.f / DM) + LN_EPS);
#pragma unroll
    for (int c = 0; c < 4; c++) {
      const int col = c * 512 + lane * 8;
      const float4 g0 = *(const float4*)(g + col), g1 = *(const float4*)(g + col + 4);
      const float4 b0 = *(const float4*)(bta + col), b1 = *(const float4*)(bta + col + 4);
      float4 o0, o1;
      o0.x = v[c * 8 + 0] * rstd * g0.x + b0.x; o0.y = v[c * 8 + 1] * rstd * g0.y + b0.y;
      o0.z = v[c * 8 + 2] * rstd * g0.z + b0.z; o0.w = v[c * 8 + 3] * rstd * g0.w + b0.w;
      o1.x = v[c * 8 + 4] * rstd * g1.x + b1.x; o1.y = v[c * 8 + 5] * rstd * g1.y + b1.y;
      o1.z = v[c * 8 + 6] * rstd * g1.z + b1.z; o1.w = v[c * 8 + 7] * rstd * g1.w + b1.w;
      if (write_bf) {
        uint4 ob;
        ob.x = pack2bf(o0.x, o0.y); ob.y = pack2bf(o0.z, o0.w);
        ob.z = pack2bf(o1.x, o1.y); ob.w = pack2bf(o1.z, o1.w);
        *(uint4*)(p.xb + (size_t)row * LDX + col) = ob;
      } else {
        *(float4*)(outf + (size_t)row * DM + col) = o0;
        *(float4*)(outf + (size_t)row * DM + col + 4) = o1;
      }
    }
#pragma unroll
    for (int c = 0; c < 4; c++) w[c] = wn[c];
    row = nrow;
  }
}

__device__ void phase_peer_route(const Params& p, char* lds, int layer) {
  const int tid_ = otid();
  char* ql = lds;
  char* skl = lds + 67584;
  float* keysl = (float*)lds;
  const u16* Wt = p.wt_q + (size_t)layer * 2048 * LDX;
  const int ntiles = (TOK / 128) * 8;
  for (int it = 0;; it++) {
    int mt, hd;
    if (!tile_map(it, TOK / 128, 8, mt, hd)) break;
    const int m0 = mt * 128, n0 = hd * 256;
    f32x4 acc[4][4];
#pragma unroll
    for (int i = 0; i < 4; i++)
#pragma unroll
      for (int j = 0; j < 4; j++) acc[i][j] = (f32x4){0.f, 0.f, 0.f, 0.f};
    __syncthreads();
    gemm_mainloop(p.xb + (size_t)m0 * LDX, LDX, Wt + (size_t)n0 * LDX, LDX, DM, lds, acc);
    int tid = tid_; asm volatile("" : "+v"(tid));
    const int lane = tid & 63, wave = tid >> 6, wm = wave >> 2, wn = wave & 3, fr = lane & 15, fq = lane >> 4;
    const int r32 = lane & 31, h32 = lane >> 5;
#pragma unroll
    for (int i = 0; i < 4; i++)
#pragma unroll
      for (int j = 0; j < 4; j++) {
        const int nl = wn * 64 + i * 16 + fq * 4, ml = wm * 64 + j * 16 + fr;
        uint2 o;
        o.x = pack2bf(acc[i][j][0], acc[i][j][1]);
        o.y = pack2bf(acc[i][j][2], acc[i][j][3]);
        *(uint2*)(ql + ml * 528 + nl * 2) = o;
      }
    {
      const u16* sksrc = p.sk + (size_t)(layer * 8 + hd) * 2 * 128 * 128;
#pragma unroll
      for (int i = 0; i < 8; i++) {
        const int id = tid + NT * i, row = id >> 4, c = id & 15;
        *(uint4*)(skl + row * 272 + c * 16) = *(const uint4*)(sksrc + row * 128 + c * 8);
      }
    }
    __syncthreads();
    const int pp = wave >> 2, tb = wave & 3;
    float L[16];
    {
      f32x16 sacc[4];
#pragma unroll
      for (int kt = 0; kt < 4; kt++)
#pragma unroll
        for (int r = 0; r < 16; r++) sacc[kt][r] = 0.f;
#pragma unroll
      for (int s = 0; s < 8; s++) {
        const bfx8 bq = *(const bfx8*)(ql + (tb * 32 + r32) * 528 + (pp * 128 + s * 16 + h32 * 8) * 2);
#pragma unroll
        for (int kt = 0; kt < 4; kt++) {
          const bfx8 ak = *(const bfx8*)(skl + (pp * 128 + kt * 32 + r32) * 272 + (s * 16 + h32 * 8) * 2);
          sacc[kt] = __builtin_amdgcn_mfma_f32_32x32x16_bf16(ak, bq, sacc[kt], 0, 0, 0);
        }
      }
      float G[16];
#pragma unroll
      for (int kt = 0; kt < 4; kt++) {
#pragma unroll
        for (int r = 0; r < 16; r++) {
          const unsigned key = 32 * kt + (r & 3) + 8 * (r >> 2) + 4 * h32;
          G[r] = __uint_as_float((__float_as_uint(sacc[kt][r]) & ~127u) | key);
        }
        sort16_desc(G);
        if (kt == 0) {
#pragma unroll
          for (int i = 0; i < 16; i++) L[i] = G[i];
        } else {
          merge16_desc(L, G);
        }
      }
    }
    {
      float O[16];
#pragma unroll
      for (int i = 0; i < 16; i++) O[i] = __shfl_xor(L[i], 32);
      merge16_desc(L, O);
    }
    __syncthreads();
    if (h32 == 0) {
#pragma unroll
      for (int i = 0; i < 16; i++) keysl[(tb * 32 + r32) * 33 + pp * 16 + i] = L[i];
    }
    __syncthreads();
    if (tid < 128) {
      float k0[16], k1[16], Bst[16];
#pragma unroll
      for (int i = 0; i < 16; i++) {
        k0[i] = clr7(keysl[tid * 33 + i]);
        k1[i] = clr7(keysl[tid * 33 + 16 + i]);
        Bst[i] = -INFINITY;
      }
#pragma unroll
      for (int i = 0; i < 16; i++)
#pragma unroll
        for (int j = 0; j < 16; j++)
          if ((i + 1) * (j + 1) <= 16) {
            const float v = k0[i] + k1[j];
            const float xv = __uint_as_float((__float_as_uint(v) & ~255u) | (unsigned)(i * 16 + j));
            INSERT16(Bst, xv);
          }
      float bv[16];
      int ei[16];
      float mxv = -INFINITY;
#pragma unroll
      for (int k = 0; k < 16; k++) {
        const unsigned pl = __float_as_uint(Bst[k]) & 255u;
        const float a = keysl[tid * 33 + (pl >> 4)], bq = keysl[tid * 33 + 16 + (pl & 15)];
        bv[k] = clr7(a) + clr7(bq);
        ei[k] = (int)((__float_as_uint(a) & 127u) * 128u + (__float_as_uint(bq) & 127u));
        mxv = fmaxf(mxv, bv[k]);
      }
      float ssum = 0.f;
#pragma unroll
      for (int k = 0; k < 16; k++) {
        bv[k] = __expf(bv[k] - mxv);
        ssum += bv[k];
      }
      const float inv = 1.f / ssum;
      const size_t ob = (size_t)(m0 + tid) * 128 + hd * 16;
#pragma unroll
      for (int k = 0; k < 16; k += 4)
        *(float4*)(p.pk_gate + ob + k) = make_float4(bv[k] * inv, bv[k + 1] * inv, bv[k + 2] * inv, bv[k + 3] * inv);
#pragma unroll
      for (int k = 0; k < 16; k += 8) {
        uint4 w4;
        w4.x = (unsigned)ei[k + 0] | ((unsigned)ei[k + 1] << 16);
        w4.y = (unsigned)ei[k + 2] | ((unsigned)ei[k + 3] << 16);
        w4.z = (unsigned)ei[k + 4] | ((unsigned)ei[k + 5] << 16);
        w4.w = (unsigned)ei[k + 6] | ((unsigned)ei[k + 7] << 16);
        *(uint4*)(p.pk_idx + ob + k) = w4;
      }
    }
  }
}

__device__ __forceinline__ float dot4f8(unsigned w, float x0, float x1, float x2, float x3, float a) {
  const f32x2 lo = __builtin_amdgcn_cvt_pk_f32_fp8((int)w, false);
  const f32x2 hi = __builtin_amdgcn_cvt_pk_f32_fp8((int)w, true);
  a = fmaf(lo.x, x0, a);
  a = fmaf(lo.y, x1, a);
  a = fmaf(hi.x, x2, a);
  a = fmaf(hi.y, x3, a);
  return a;
}
__device__ __forceinline__ void fma4f8(unsigned w, float a, float& f0, float& f1, float& f2, float& f3) {
  const f32x2 lo = __builtin_amdgcn_cvt_pk_f32_fp8((int)w, false);
  const f32x2 hi = __builtin_amdgcn_cvt_pk_f32_fp8((int)w, true);
  f0 = fmaf(a, lo.x, f0);
  f1 = fmaf(a, lo.y, f1);
  f2 = fmaf(a, hi.x, f2);
  f3 = fmaf(a, hi.y, f3);
}

__device__ __forceinline__ unsigned xcc_id() { return (unsigned)__builtin_amdgcn_s_getreg((3 << 11) | 20) & 7u; }
__device__ __forceinline__ int slice_order(unsigned x, int qi) {
  const int d = qi >> 1;
  return (int)(((x + d) & 7u) + ((qi & 1) ? 8u : 0u));
}
constexpr int WTOK = 8;
constexpr int ITEM_TOK = WTOK;
constexpr int NITEMS = TOK / ITEM_TOK;

__device__ __forceinline__ f32x2 pkfma(f32x2 a, f32x2 b, f32x2 c) { return __builtin_elementwise_fma(a, b, c); }
__device__ __forceinline__ f32x2 dot4f8p(unsigned w, f32x2 x01, f32x2 x23, f32x2 acc) {
  const f32x2 lo = __builtin_amdgcn_cvt_pk_f32_fp8((int)w, false);
  const f32x2 hi = __builtin_amdgcn_cvt_pk_f32_fp8((int)w, true);
  acc = pkfma(lo, x01, acc);
  acc = pkfma(hi, x23, acc);
  return acc;
}
__device__ __forceinline__ float dot16f8(const uint4 u, const f32x2 (&x)[8]) {
  f32x2 a = {0.f, 0.f};
  a = dot4f8p(u.x, x[0], x[1], a);
  a = dot4f8p(u.y, x[2], x[3], a);
  a = dot4f8p(u.z, x[4], x[5], a);
  a = dot4f8p(u.w, x[6], x[7], a);
  return a.x + a.y;
}
__device__ __forceinline__ void fma4f8p(unsigned w, f32x2 aa, f32x2& f01, f32x2& f23) {
  const f32x2 lo = __builtin_amdgcn_cvt_pk_f32_fp8((int)w, false);
  const f32x2 hi = __builtin_amdgcn_cvt_pk_f32_fp8((int)w, true);
  f01 = pkfma(lo, aa, f01);
  f23 = pkfma(hi, aa, f23);
}

struct Aux16 { float4 a, b, c, d; };
struct Idx16 { uint4 a, b; };
struct Tab4 { uint4 r[4]; };

template <bool VSIDE>
struct PeerItem {
  const Params& p;
  const unsigned char* tb;
  int s, g, w, lane;
  float* stage;
  __device__ __forceinline__ Idx16 load_idx(size_t tok) const {
    const uint4* ip = (const uint4*)(p.pk_idx + tok * 128 + g * 16);
    Idx16 r;
    r.a = ip[0]; r.b = ip[1];
    return r;
  }
  __device__ __forceinline__ Aux16 load_aux(size_t tok) const {
    Aux16 r;
    if (VSIDE) {
      const float4* ap = (const float4*)(p.act + tok * 128 + g * 16);
      r.a = ap[0]; r.b = ap[1]; r.c = ap[2]; r.d = ap[3];
    } else {
      const uint4* xp = (const uint4*)(p.xb + tok * LDX + s * 128 + w * 16);
      const uint4 x0 = xp[0], x1 = xp[1];
      r.a = make_float4(bflo(x0.x), bfhi(x0.x), bflo(x0.y), bfhi(x0.y));
      r.b = make_float4(bflo(x0.z), bfhi(x0.z), bflo(x0.w), bfhi(x0.w));
      r.c = make_float4(bflo(x1.x), bfhi(x1.x), bflo(x1.y), bfhi(x1.y));
      r.d = make_float4(bflo(x1.z), bfhi(x1.z), bflo(x1.w), bfhi(x1.w));
    }
    return r;
  }
  __device__ __forceinline__ void issue(unsigned w0, unsigned w1, Tab4& t) const {
    t.r[0] = *(const uint4*)(tb + (size_t)((w0 & 0xFFFFu) << 7));
    t.r[1] = *(const uint4*)(tb + (size_t)((w0 >> 9) & 0xFFFFFF80u));
    t.r[2] = *(const uint4*)(tb + (size_t)((w1 & 0xFFFFu) << 7));
    t.r[3] = *(const uint4*)(tb + (size_t)((w1 >> 9) & 0xFFFFFF80u));
  }
  template <int Q>
  __device__ __forceinline__ void quarter(const Tab4& t, const Aux16& ax, f32x2 (&v)[8]) const {
    if (!VSIDE) {
      const f32x2 x[8] = {{ax.a.x, ax.a.y}, {ax.a.z, ax.a.w}, {ax.b.x, ax.b.y}, {ax.b.z, ax.b.w},
                          {ax.c.x, ax.c.y}, {ax.c.z, ax.c.w}, {ax.d.x, ax.d.y}, {ax.d.z, ax.d.w}};
      const float d0 = dot16f8(t.r[0], x), d1 = dot16f8(t.r[1], x), d2 = dot16f8(t.r[2], x), d3 = dot16f8(t.r[3], x);
      v[2 * Q] = (f32x2){d0, d1};
      v[2 * Q + 1] = (f32x2){d2, d3};
    } else {
      const float4 a4 = Q == 0 ? ax.a : Q == 1 ? ax.b : Q == 2 ? ax.c : ax.d;
      const float av[4] = {a4.x, a4.y, a4.z, a4.w};
#pragma unroll
      for (int j = 0; j < 4; j++) {
        const f32x2 aa = {av[j], av[j]};
        fma4f8p(t.r[j].x, aa, v[0], v[1]);
        fma4f8p(t.r[j].y, aa, v[2], v[3]);
        fma4f8p(t.r[j].z, aa, v[4], v[5]);
        fma4f8p(t.r[j].w, aa, v[6], v[7]);
      }
    }
  }
  __device__ __forceinline__ void finish(const f32x2 (&v2)[8], int tt) const {
    const float v[16] = {v2[0].x, v2[0].y, v2[1].x, v2[1].y, v2[2].x, v2[2].y, v2[3].x, v2[3].y,
                         v2[4].x, v2[4].y, v2[5].x, v2[5].y, v2[6].x, v2[6].y, v2[7].x, v2[7].y};
    const int sh = VSIDE ? 3 : 0;
    const bool c0 = ((lane >> sh) & 1) != 0, c1 = ((lane >> sh) & 2) != 0, c2 = ((lane >> sh) & 4) != 0;
    float r8[8], r4[4], r2[2];
#pragma unroll
    for (int i = 0; i < 8; i++) r8[i] = (c0 ? v[2 * i + 1] : v[2 * i]) + __shfl_xor(c0 ? v[2 * i] : v[2 * i + 1], 1 << sh);
#pragma unroll
    for (int i = 0; i < 4; i++) r4[i] = (c1 ? r8[2 * i + 1] : r8[2 * i]) + __shfl_xor(c1 ? r8[2 * i] : r8[2 * i + 1], 2 << sh);
#pragma unroll
    for (int i = 0; i < 2; i++) r2[i] = (c2 ? r4[2 * i + 1] : r4[2 * i]) + __shfl_xor(c2 ? r4[2 * i] : r4[2 * i + 1], 4 << sh);
    float* lw = stage + tt * 128 + (VSIDE ? (w * 16 + g) : (g * 16 + w));
    lw[0] = r2[0];
    lw[8] = r2[1];
  }
  __device__ __forceinline__ void flush(size_t tok0, int ntok) const {
    for (int tt = 0; tt < ntok; tt++) {
      float2 r = *(const float2*)(stage + tt * 128 + 2 * lane);
      if (!VSIDE) {
        *(unsigned*)(p.hpart + ((size_t)s * TOK + tok0 + tt) * 128 + 2 * lane) = pack2bf(r.x, r.y);
      } else {
        const unsigned xw = *(const unsigned*)(p.xb + (tok0 + tt) * LDX + s * 128 + 2 * lane);
        r.x += ALPHA * bflo(xw);
        r.y += ALPHA * bfhi(xw);
        *(unsigned*)(p.yb + (tok0 + tt) * DM + s * 128 + 2 * lane) = pack2bf(r.x, r.y);
      }
    }
  }
  template <bool ISSUE, bool TOPAUX, bool TOPIDX>
  __device__ __forceinline__ void step(Tab4 (&Q)[4], const Aux16& axCur, const Idx16& eNext, Aux16& axNext, Idx16& eNext2,
                                       size_t tokn, int tt) const {
    if (TOPAUX) axNext = load_aux(tokn);
    if (TOPIDX) eNext2 = load_idx(tokn + 1);
    f32x2 v[8];
#pragma unroll
    for (int j = 0; j < 8; j++) v[j] = (f32x2){0.f, 0.f};
    quarter<0>(Q[0], axCur, v);
    if (ISSUE) issue(eNext.a.x, eNext.a.y, Q[0]);
    quarter<1>(Q[1], axCur, v);
    if (ISSUE) issue(eNext.a.z, eNext.a.w, Q[1]);
    quarter<2>(Q[2], axCur, v);
    if (ISSUE) issue(eNext.b.x, eNext.b.y, Q[2]);
    quarter<3>(Q[3], axCur, v);
    if (ISSUE) issue(eNext.b.z, eNext.b.w, Q[3]);
    finish(v, tt);
  }
  __device__ __forceinline__ void run(size_t tok0) const {
    Tab4 Q[4];
    Idx16 eE = load_idx(tok0), eO;
    Aux16 axE = load_aux(tok0), axO;
    issue(eE.a.x, eE.a.y, Q[0]);
    issue(eE.a.z, eE.a.w, Q[1]);
    issue(eE.b.x, eE.b.y, Q[2]);
    issue(eE.b.z, eE.b.w, Q[3]);
    eO = load_idx(tok0 + 1);
#pragma unroll
    for (int t = 0; t < WTOK - 2; t += 2) {
      step<true, true, true>(Q, axE, eO, axO, eE, tok0 + t + 1, t);
      step<true, true, true>(Q, axO, eE, axE, eO, tok0 + t + 2, t + 1);
    }
    step<true, true, false>(Q, axE, eO, axO, eE, tok0 + WTOK - 1, WTOK - 2);
    step<false, false, false>(Q, axO, eE, axE, eO, tok0 + WTOK - 1, WTOK - 1);
    flush(tok0, WTOK);
  }
};

__device__ __forceinline__ unsigned wave_pull(unsigned* q, int lane) {
  unsigned v = 0;
  if (lane == 0) v = __hip_atomic_fetch_add(q, 1u, __ATOMIC_RELAXED, __HIP_MEMORY_SCOPE_AGENT);
  return (unsigned)__builtin_amdgcn_readfirstlane((int)v);
}

template <bool VSIDE>
__device__ void phase_peer_slices(const Params& p, char* lds, int layer, unsigned* queues) {
  const int tid = otid(), lane = tid & 63, wave = tid >> 6;
  const unsigned x = xcc_id();
  const unsigned char* tbase = (VSIDE ? p.vb8 : p.ub8) + (size_t)layer * 16384 * 2048;
  for (int qi = 0; qi < 16; qi++) {
    const int s = slice_order(x, qi < 2 ? (qi ^ (wave & 1)) : qi);
    PeerItem<VSIDE> pi{p, tbase + (size_t)s * (16384 * 128) + (lane & 7) * 16, s, lane >> 3, lane & 7, lane, (float*)(lds + 64 + wave * (WTOK * 512))};
    unsigned nxt = wave_pull(queues + s * 64, lane);
    while (nxt < (unsigned)NITEMS) {
      const unsigned cur = nxt;
      unsigned nv = 0;
      if (lane == 0) nv = __hip_atomic_fetch_add(queues + s * 64, 1u, __ATOMIC_RELAXED, __HIP_MEMORY_SCOPE_AGENT);
      pi.run((size_t)cur * ITEM_TOK);
      nxt = (unsigned)__builtin_amdgcn_readfirstlane((int)nv);
    }
  }
}

__device__ void phase_peer_act(const Params& p, int layer) {
  const float* uinv = p.uinv + layer * 16384;
  const float* vinv = p.vinv + layer * 16384;
  for (size_t i8 = (size_t)blockIdx.x * NT + otid(); i8 < (size_t)TOK * 16; i8 += (size_t)gridDim.x * NT) {
    const size_t i = i8 * 8;
    uint4 hp[16];
#pragma unroll
    for (int s = 0; s < 16; s++) hp[s] = *(const uint4*)(p.hpart + (size_t)s * TOK * 128 + i);
    const uint4 ew = *(const uint4*)(p.pk_idx + i);
    const float4 g0 = *(const float4*)(p.pk_gate + i), g1 = *(const float4*)(p.pk_gate + i + 4);
    float h[8];
#pragma unroll
    for (int j = 0; j < 8; j++) h[j] = 0.f;
#pragma unroll
    for (int s = 0; s < 16; s++) {
      h[0] += bflo(hp[s].x); h[1] += bfhi(hp[s].x);
      h[2] += bflo(hp[s].y); h[3] += bfhi(hp[s].y);
      h[4] += bflo(hp[s].z); h[5] += bfhi(hp[s].z);
      h[6] += bflo(hp[s].w); h[7] += bfhi(hp[s].w);
    }
    const int e[8] = {(int)(ew.x & 0xFFFF), (int)(ew.x >> 16), (int)(ew.y & 0xFFFF), (int)(ew.y >> 16),
                      (int)(ew.z & 0xFFFF), (int)(ew.z >> 16), (int)(ew.w & 0xFFFF), (int)(ew.w >> 16)};
    const float gt[8] = {g0.x, g0.y, g0.z, g0.w, g1.x, g1.y, g1.z, g1.w};
    float a[8];
#pragma unroll
    for (int j = 0; j < 8; j++) {
      const float hv = h[j] * uinv[e[j]];
      a[j] = gt[j] * 0.5f * hv * (1.f + erff(hv * 0.70710678118654752f)) * vinv[e[j]];
    }
    *(float4*)(p.act + i) = make_float4(a[0], a[1], a[2], a[3]);
    *(float4*)(p.act + i + 4) = make_float4(a[4], a[5], a[6], a[7]);
  }
}

template <int W>
__device__ __forceinline__ void poolmix_item(const Params& p, int t, int c8) {
  const int s = t & 2047;
  const int cnt = min(s + 1, W);
  const u16* xp = p.xb + (size_t)t * LDX + c8;
  uint4 b[W];
#pragma unroll
  for (int r = 0; r < W; r++) {
    const int rr = r < cnt ? r : 0;
    b[r] = *(const uint4*)(xp - (size_t)rr * LDX);
  }
  float a[8] = {bflo(b[0].x), bfhi(b[0].x), bflo(b[0].y), bfhi(b[0].y), bflo(b[0].z), bfhi(b[0].z), bflo(b[0].w), bfhi(b[0].w)};
  float sm[8];
#pragma unroll
  for (int j = 0; j < 8; j++) sm[j] = a[j];
#pragma unroll
  for (int r = 1; r < W; r++) {
    const float m = r < cnt ? 1.f : 0.f;
    sm[0] += m * bflo(b[r].x); sm[1] += m * bfhi(b[r].x);
    sm[2] += m * bflo(b[r].y); sm[3] += m * bfhi(b[r].y);
    sm[4] += m * bflo(b[r].z); sm[5] += m * bfhi(b[r].z);
    sm[6] += m * bflo(b[r].w); sm[7] += m * bfhi(b[r].w);
  }
  const float ic = 1.f / (float)cnt;
  uint4 o;
  o.x = pack2bf(sm[0] * ic - a[0], sm[1] * ic - a[1]);
  o.y = pack2bf(sm[2] * ic - a[2], sm[3] * ic - a[3]);
  o.z = pack2bf(sm[4] * ic - a[4], sm[5] * ic - a[5]);
  o.w = pack2bf(sm[6] * ic - a[6], sm[7] * ic - a[7]);
  *(uint4*)(p.att + (size_t)t * LDX + c8) = o;
}
__device__ void phase_poolmix(const Params& p) {
  for (size_t id = (size_t)blockIdx.x * NT + otid(); id < (size_t)TOK * 256; id += (size_t)gridDim.x * NT) {
    const int t = (int)(id >> 8), c8 = (int)(id & 255) * 8;
    const int grp = c8 >> 9;
    if (grp == 0) poolmix_item<2>(p, t, c8);
    else if (grp == 1) poolmix_item<4>(p, t, c8);
    else if (grp == 2) poolmix_item<8>(p, t, c8);
    else poolmix_item<16>(p, t, c8);
  }
}

__device__ __forceinline__ void run_phase(const Params& p, char* lds, int ph) {
  switch (ph) {
    case 0: phase_prep(p, lds); break;
    case 1: phase_qkv(p, lds); break;
    case 2: phase_attn(p, lds); break;
    case 3: phase_gemm_resid<false>(p, lds, p.att, p.wt_o, p.x, nullptr); break;
    case 4: phase_ln(p, p.ln_g, p.ln_b, nullptr, true); break;
    case 5: phase_peer_route(p, lds, 0); break;
    case 6: phase_peer_slices<false>(p, lds, 0, p.bar + 64 * 1); break;
    case 7: phase_peer_act(p, 0); break;
    case 8: phase_peer_slices<true>(p, lds, 0, p.bar + 64 * 17); break;
    case 9: phase_ln(p, p.ln_g + DM, p.ln_b + DM, nullptr, true); break;
    case 10: phase_poolmix(p); break;
    case 11: phase_gemm_resid<true>(p, lds, p.att, p.wt_pool, nullptr, p.pool_scale); break;
    case 12: phase_ln(p, p.ln_g + 2 * DM, p.ln_b + 2 * DM, nullptr, true); break;
    case 13: phase_peer_route(p, lds, 1); break;
    case 14: phase_peer_slices<false>(p, lds, 1, p.bar + 64 * 33); break;
    case 15: phase_peer_act(p, 1); break;
    case 16: phase_peer_slices<true>(p, lds, 1, p.bar + 64 * 49); break;
    case 17: phase_ln(p, p.ln_g + 3 * DM, p.ln_b + 3 * DM, p.out, false); break;
  }
}

#if MULTI
template <int PH>
__global__ void __launch_bounds__(NT) phase_kernel(Params p) {
  __shared__ __attribute__((aligned(16))) char lds[LDS_BYTES];
  run_phase(p, lds, PH);
}
#else
#define XB_TMO      128
#define XB_XCNT(j)  (256  + 64 * (j))
#define XB_XSUB(j)  (1280 + 64 * (j))
#define XB_XGEN(j)  (2304 + 64 * (j))
#define XB_TOP      3328
#define XB_TOPGEN   3392
#define XCD_BAR_WORDS 3456
#define XB_SPIN_CAP (1u << 22)
__device__ __forceinline__ unsigned xb_ld(unsigned* q) { return __hip_atomic_load(q, __ATOMIC_RELAXED, __HIP_MEMORY_SCOPE_AGENT); }
__device__ __forceinline__ unsigned xb_add(unsigned* q, unsigned v) { return __hip_atomic_fetch_add(q, v, __ATOMIC_RELAXED, __HIP_MEMORY_SCOPE_AGENT); }
__device__ __forceinline__ unsigned xb_xcc_id() { return (unsigned)__builtin_amdgcn_s_getreg((3 << 11) | 20) & 0xFu; }
#define XB_SPIN(cond, bar) do { unsigned _sp = 0; while (cond) { __builtin_amdgcn_s_sleep(1); \
    if ((++_sp & 255u) == 0u) { if (xb_ld(&(bar)[XB_TMO])) break; if (_sp > XB_SPIN_CAP) { atomicAdd(&(bar)[XB_TMO], 1u); break; } } } } while (0)
struct XcdBarrier { unsigned* bar; unsigned x; volatile unsigned* st; };
__device__ __forceinline__ XcdBarrier xcd_barrier_post(unsigned* bar, volatile unsigned* st) {
  XcdBarrier b; b.bar = bar; b.x = xb_xcc_id(); b.st = st;
  if (threadIdx.x == 0) (void)xb_add(&bar[XB_XCNT(b.x)], 1u);
  return b;
}
__device__ __forceinline__ void xcd_barrier_complete(unsigned* bar, unsigned x, unsigned& nloc, unsigned& nx) {
  const unsigned G = gridDim.x * gridDim.y * gridDim.z;
  unsigned sum, cnt, mine, sp = 0u;
  for (;;) {
    sum = 0u; cnt = 0u; mine = 0u;
#pragma unroll
    for (unsigned j = 0; j < 16; ++j) { const unsigned c = xb_ld(&bar[XB_XCNT(j)]); sum += c; cnt += (c > 0u) ? 1u : 0u; mine = (j == x) ? c : mine; }
    if (sum == G) break;
    __builtin_amdgcn_s_sleep(1);
    if ((++sp & 255u) == 0u) { if (xb_ld(&bar[XB_TMO])) break; if (sp > XB_SPIN_CAP) { atomicAdd(&bar[XB_TMO], 1u); break; } }
  }
  nloc = mine > 0u ? mine : 1u; nx = cnt > 0u ? cnt : 1u;
}
__device__ __forceinline__ void xcd_barrier(const XcdBarrier& b) {
  asm volatile("s_waitcnt vmcnt(0)" ::: "memory");
  __syncthreads();
  if (threadIdx.x == 0) {
    unsigned* bar = b.bar;
    __builtin_amdgcn_s_waitcnt(0);
    unsigned nloc = b.st[0], nx = b.st[1];
    if (nloc == 0u) { xcd_barrier_complete(bar, b.x, nloc, nx); b.st[0] = nloc; b.st[1] = nx; }
    const unsigned old = xb_add(&bar[XB_XSUB(b.x)], 1u);
    const unsigned gen = old / nloc;
    if (old + 1u == (gen + 1u) * nloc) {
      __builtin_amdgcn_fence(__ATOMIC_RELEASE, "agent");
      asm volatile("s_waitcnt vmcnt(0)" ::: "memory");
      const unsigned og = xb_add(&bar[XB_TOP], 1u);
      const unsigned tg = og / nx;
      if (og + 1u == (tg + 1u) * nx) xb_add(&bar[XB_TOPGEN], 1u);
      else XB_SPIN(xb_ld(&bar[XB_TOPGEN]) == tg, bar);
      __builtin_amdgcn_fence(__ATOMIC_ACQUIRE, "agent");
      xb_add(&bar[XB_XGEN(b.x)], 1u);
      asm volatile("s_waitcnt vmcnt(0)" ::: "memory");
    } else {
      XB_SPIN(xb_ld(&bar[XB_XGEN(b.x)]) == gen, bar);
      __builtin_amdgcn_fence(__ATOMIC_ACQUIRE, "agent");
      asm volatile("s_waitcnt vmcnt(0)" ::: "memory");
    }
  }
  __syncthreads();
}

__device__ __forceinline__ void grid_bar(unsigned* ctr, unsigned target) {
  asm volatile("s_waitcnt vmcnt(0)" ::: "memory");
  __syncthreads();
  if (threadIdx.x == 0) {
    __builtin_amdgcn_fence(__ATOMIC_RELEASE, "agent");
    asm volatile("s_waitcnt vmcnt(0)" ::: "memory");
    __hip_atomic_fetch_add(ctr, 1u, __ATOMIC_RELAXED, __HIP_MEMORY_SCOPE_AGENT);
    while (__hip_atomic_load(ctr, __ATOMIC_RELAXED, __HIP_MEMORY_SCOPE_AGENT) < target) __builtin_amdgcn_s_sleep(2);
    __builtin_amdgcn_fence(__ATOMIC_ACQUIRE, "agent");
    asm volatile("s_waitcnt vmcnt(0)" ::: "memory");
  }
  __syncthreads();
}

__global__ void __launch_bounds__(NT) mega_kernel(Params p) {
  __shared__ __attribute__((aligned(16))) char lds[LDS_BYTES + 16];
  cg::grid_group grid = cg::this_grid();
  volatile unsigned* xst = (volatile unsigned*)(lds + LDS_BYTES);
  if (threadIdx.x == 0) { xst[0] = 0u; xst[1] = 0u; }
  __syncthreads();
  const XcdBarrier xbar = xcd_barrier_post(p.xbar, xst);
  run_phase(p, lds, 0); grid.sync();
  run_phase(p, lds, 1); xcd_barrier(xbar);
  run_phase(p, lds, 2); xcd_barrier(xbar);
  run_phase(p, lds, 3); xcd_barrier(xbar);
  run_phase(p, lds, 4); xcd_barrier(xbar);
  run_phase(p, lds, 5); xcd_barrier(xbar);
  run_phase(p, lds, 6); xcd_barrier(xbar);
  run_phase(p, lds, 7); xcd_barrier(xbar);
  run_phase(p, lds, 8); xcd_barrier(xbar);
  run_phase(p, lds, 9); xcd_barrier(xbar);
  run_phase(p, lds, 10); xcd_barrier(xbar);
  run_phase(p, lds, 11); xcd_barrier(xbar);
  run_phase(p, lds, 12); xcd_barrier(xbar);
  run_phase(p, lds, 13); xcd_barrier(xbar);
  run_phase(p, lds, 14); xcd_barrier(xbar);
  run_phase(p, lds, 15); xcd_barrier(xbar);
  run_phase(p, lds, 16); xcd_barrier(xbar);
  run_phase(p, lds, 17);
}
#endif

extern "C" void kernel_launch(void* const* d_in, const int* in_sizes, int n_in, void* d_out, int out_size, void* d_ws,
                              size_t ws_size, hipStream_t stream) {
  Params p{};
  p.x = (const float*)d_in[0];
  p.w_qkv = (const float*)d_in[1];
  p.w_o = (const float*)d_in[2];
  p.sinks = (const float*)d_in[3];
  p.pool_w = (const float*)d_in[4];
  p.pool_scale = (const float*)d_in[5];
  p.ln_g = (const float*)d_in[6];
  p.ln_b = (const float*)d_in[7];
  p.wq = (const float*)d_in[8];
  p.subkeys = (const float*)d_in[9];
  p.pu = (const float*)d_in[10];
  p.pv = (const float*)d_in[11];
  p.out = (float*)d_out;
  char* w = (char*)d_ws;
  size_t off = 0;
  auto take = [&](size_t bytes) {
    char* r = w + off;
    off += (bytes + 255) & ~(size_t)255;
    return r;
  };
  p.wt_qkv = (u16*)take((size_t)2560 * LDX * 2);
  p.wt_o = (u16*)take((size_t)2048 * LDX * 2);
  p.wt_pool = (u16*)take((size_t)4 * 512 * LDP * 2);
  p.wt_q = (u16*)take((size_t)2 * 2048 * LDX * 2);
  p.sk = (u16*)take((size_t)2 * 8 * 2 * 128 * 128 * 2);
  p.ub8 = (unsigned char*)take((size_t)2 * 16384 * 2048);
  p.vb8 = (unsigned char*)take((size_t)2 * 16384 * 2048);
  p.uinv = (float*)take((size_t)2 * 16384 * 4);
  p.vinv = (float*)take((size_t)2 * 16384 * 4);
  p.xb = (u16*)take((size_t)TOK * LDX * 2);
  p.qkv = (u16*)take((size_t)TOK * QKVD * 2);
  p.att = (u16*)take((size_t)TOK * LDX * 2);
  p.yb = (u16*)take((size_t)TOK * DM * 2);
  p.pk_idx = (u16*)take((size_t)TOK * 128 * 2 + 4096);
  p.pk_gate = (float*)take((size_t)TOK * 128 * 4);
  p.bar = (unsigned*)take(65 * 256 + XCD_BAR_WORDS * 4);
  p.xbar = p.bar + 65 * 64;
  p.act = (float*)take((size_t)TOK * 128 * 4);
  p.hpart = (u16*)p.qkv;
  if (off > ws_size) {
    fprintf(stderr, "workspace too small: need %zu have %zu\n", off, ws_size);
    return;
  }
#if MULTI
  const int grid = 256;
  phase_kernel<0><<<grid, NT, 0, stream>>>(p);
  phase_kernel<1><<<grid, NT, 0, stream>>>(p);
  phase_kernel<2><<<grid, NT, 0, stream>>>(p);
  phase_kernel<3><<<grid, NT, 0, stream>>>(p);
  phase_kernel<4><<<grid, NT, 0, stream>>>(p);
  phase_kernel<5><<<grid, NT, 0, stream>>>(p);
  phase_kernel<6><<<grid, NT, 0, stream>>>(p);
  phase_kernel<7><<<grid, NT, 0, stream>>>(p);
  phase_kernel<8><<<grid, NT, 0, stream>>>(p);
  phase_kernel<9><<<grid, NT, 0, stream>>>(p);
  phase_kernel<10><<<grid, NT, 0, stream>>>(p);
  phase_kernel<11><<<grid, NT, 0, stream>>>(p);
  phase_kernel<12><<<grid, NT, 0, stream>>>(p);
  phase_kernel<13><<<grid, NT, 0, stream>>>(p);
  phase_kernel<14><<<grid, NT, 0, stream>>>(p);
  phase_kernel<15><<<grid, NT, 0, stream>>>(p);
  phase_kernel<16><<<grid, NT, 0, stream>>>(p);
  phase_kernel<17><<<grid, NT, 0, stream>>>(p);
#else
  static int grid_blocks = 0;
  if (!grid_blocks) {
    int dev = 0, cus = 0, per_cu = 0;
    hipGetDevice(&dev);
    hipDeviceGetAttribute(&cus, hipDeviceAttributeMultiprocessorCount, dev);
    hipOccupancyMaxActiveBlocksPerMultiprocessor(&per_cu, mega_kernel, NT, 0);
    if (per_cu > 1) per_cu = 1;
    grid_blocks = cus * per_cu;
  }
  hipMemsetAsync(p.bar, 0, 65 * 256 + XCD_BAR_WORDS * 4, stream);
  void* args[] = {&p};
  hipError_t e = hipLaunchCooperativeKernel((void*)mega_kernel, dim3(grid_blocks), dim3(NT), args, 0, stream);
  if (e != hipSuccess) fprintf(stderr, "cooperative launch failed: %s (grid %d)\n", hipGetErrorString(e), grid_blocks);
#endif
}
```

```cpp
#include <hip/hip_runtime.h>
#include <hip/hip_cooperative_groups.h>
#include <cstdio>
namespace cg = cooperative_groups;

#ifndef MULTI
#define MULTI 0
#endif

typedef unsigned short u16;
using bfx8 = __attribute__((ext_vector_type(8))) __bf16;
using bfx2 = __attribute__((ext_vector_type(2))) __bf16;
using f32x4 = __attribute__((ext_vector_type(4))) float;
using f32x16 = __attribute__((ext_vector_type(16))) float;
typedef float f32x2 __attribute__((ext_vector_type(2)));

constexpr int NT = 512;
constexpr int TOK = 16384, DM = 2048, QKVD = 2560;
constexpr int LDX = 2112, LDP = 576;
constexpr float ALPHA = 1.41421356237309515f;
constexpr float LN_EPS = 1e-5f;
constexpr int LDS_BYTES = 147456;
constexpr int NPHASE = 18;

struct Params {
  const float *x, *w_qkv, *w_o, *sinks, *pool_w, *pool_scale, *ln_g, *ln_b, *wq, *subkeys, *pu, *pv;
  float* out;
  u16 *wt_qkv, *wt_o, *wt_pool, *wt_q, *sk, *xb, *qkv, *att;
  unsigned char *ub8, *vb8;
  u16* yb;
  float *pk_gate, *uinv, *vinv;
  u16* pk_idx;
  unsigned *bar, *xbar;
  u16* hpart;
  float* act;
};

__device__ __forceinline__ int otid() {
  int t = threadIdx.x;
  asm volatile("" : "+v"(t));
  return t;
}
__device__ __forceinline__ u16 f2bf(float f) {
  unsigned u = __float_as_uint(f);
  u += 0x7FFFu + ((u >> 16) & 1u);
  return (u16)(u >> 16);
}
__device__ __forceinline__ unsigned pack2bf(float a, float b) {
  return (unsigned)f2bf(a) | ((unsigned)f2bf(b) << 16);
}
__device__ __forceinline__ float bflo(unsigned w) { return __uint_as_float(w << 16); }
__device__ __forceinline__ float bfhi(unsigned w) { return __uint_as_float(w & 0xFFFF0000u); }
__device__ __forceinline__ float dot2(unsigned a, unsigned b, float c) {
  return __builtin_amdgcn_fdot2_f32_bf16(__builtin_bit_cast(bfx2, a), __builtin_bit_cast(bfx2, b), c, false);
}
__device__ __forceinline__ float clr7(float v) { return __uint_as_float(__float_as_uint(v) & ~127u); }

#define INSERT16(L, xx)                              \
  {                                                  \
    float _x = (xx);                                 \
    _Pragma("unroll") for (int _i = 0; _i < 16; _i++) { \
      float _h = fmaxf(L[_i], _x);                   \
      _x = fminf(L[_i], _x);                         \
      L[_i] = _h;                                    \
    }                                                \
  }

__device__ __forceinline__ void sort16_desc(float (&v)[16]) {
#pragma unroll
  for (int k = 2; k <= 16; k <<= 1)
#pragma unroll
    for (int j = k >> 1; j > 0; j >>= 1)
#pragma unroll
      for (int i = 0; i < 16; i++) {
        const int l = i ^ j;
        if (l > i) {
          const bool desc = ((i & k) == 0);
          const float a = v[i], b = v[l];
          v[i] = desc ? fmaxf(a, b) : fminf(a, b);
          v[l] = desc ? fminf(a, b) : fmaxf(a, b);
        }
      }
}
__device__ __forceinline__ void merge16_desc(float (&a)[16], const float (&b)[16]) {
#pragma unroll
  for (int i = 0; i < 16; i++) a[i] = fmaxf(a[i], b[15 - i]);
#pragma unroll
  for (int j = 8; j > 0; j >>= 1)
#pragma unroll
    for (int i = 0; i < 16; i++) {
      const int l = i ^ j;
      if (l > i) {
        const float x = a[i], y = a[l];
        a[i] = fmaxf(x, y);
        a[l] = fminf(x, y);
      }
    }
}

__device__ void transpose_cvt(const float* __restrict__ src, u16* __restrict__ dst, int K, int N, int ldd, float* tile) {
  const int tilesN = N / 64, nt = tilesN * (K / 64);
  const int tid = otid();
  for (int t = blockIdx.x; t < nt; t += gridDim.x) {
    const int k0 = (t / tilesN) * 64, n0 = (t % tilesN) * 64;
    __syncthreads();
#pragma unroll
    for (int i = 0; i < 2; i++) {
      const int r = (tid >> 4) + i * 32, c4 = (tid & 15) * 4;
      const float4 v = *(const float4*)(src + (size_t)(k0 + r) * N + n0 + c4);
      tile[r * 65 + c4 + 0] = v.x;
      tile[r * 65 + c4 + 1] = v.y;
      tile[r * 65 + c4 + 2] = v.z;
      tile[r * 65 + c4 + 3] = v.w;
    }
    __syncthreads();
    const int n = tid >> 3, kc = (tid & 7) * 8;
    uint4 o;
    o.x = pack2bf(tile[(kc + 0) * 65 + n], tile[(kc + 1) * 65 + n]);
    o.y = pack2bf(tile[(kc + 2) * 65 + n], tile[(kc + 3) * 65 + n]);
    o.z = pack2bf(tile[(kc + 4) * 65 + n], tile[(kc + 5) * 65 + n]);
    o.w = pack2bf(tile[(kc + 6) * 65 + n], tile[(kc + 7) * 65 + n]);
    *(uint4*)(dst + (size_t)(n0 + n) * ldd + k0 + kc) = o;
  }
}

__device__ void cvt_bf16(const float* __restrict__ src, u16* __restrict__ dst, size_t n) {
  const size_t nch = n / 8;
  for (size_t i = (size_t)blockIdx.x * NT + otid(); i < nch; i += (size_t)gridDim.x * NT) {
    const float4 a = ((const float4*)src)[2 * i], b = ((const float4*)src)[2 * i + 1];
    uint4 o;
    o.x = pack2bf(a.x, a.y);
    o.y = pack2bf(a.z, a.w);
    o.z = pack2bf(b.x, b.y);
    o.w = pack2bf(b.z, b.w);
    ((uint4*)dst)[i] = o;
  }
}

__device__ void cvt_fp8_rows(const float* __restrict__ src, unsigned char* __restrict__ dst, float* __restrict__ inv,
                             int nrows) {
  const int tidq = otid(), lane = tidq & 63, wave = tidq >> 6;
  for (int row = blockIdx.x * 8 + wave; row < nrows; row += gridDim.x * 8) {
    const float* sr = src + (size_t)row * 2048;
    float4 v[8];
    float mx = 0.f;
#pragma unroll
    for (int c = 0; c < 8; c++) {
      v[c] = *(const float4*)(sr + c * 256 + lane * 4);
      mx = fmaxf(mx, fmaxf(fmaxf(fabsf(v[c].x), fabsf(v[c].y)), fmaxf(fabsf(v[c].z), fabsf(v[c].w))));
    }
#pragma unroll
    for (int o = 32; o > 0; o >>= 1) mx = fmaxf(mx, __shfl_xor(mx, o));
    const float sc = mx > 0.f ? 448.f / mx : 1.f;
    if (lane == 0) inv[row] = mx > 0.f ? mx * (1.f / 448.f) : 1.f;
#pragma unroll
    for (int c = 0; c < 8; c++) {
      int pk = 0;
      pk = __builtin_amdgcn_cvt_pk_fp8_f32(v[c].x * sc, v[c].y * sc, pk, false);
      pk = __builtin_amdgcn_cvt_pk_fp8_f32(v[c].z * sc, v[c].w * sc, pk, true);
      const int lay = row >> 14, er = row & 16383, sl = 2 * c + (lane >> 5);
      *(int*)(dst + (size_t)lay * (16384 * 2048) + (size_t)sl * (16384 * 128) + (size_t)er * 128 + (lane & 31) * 4) = pk;
    }
  }
}

__device__ void cvt_bf16_rows(const float* __restrict__ src, u16* __restrict__ dst, int nrows) {
  const size_t nch = (size_t)nrows * 256;
  for (size_t i = (size_t)blockIdx.x * NT + otid(); i < nch; i += (size_t)gridDim.x * NT) {
    const size_t row = i >> 8;
    const int c8 = (int)(i & 255) * 8;
    const float4 a = *(const float4*)(src + row * DM + c8), b = *(const float4*)(src + row * DM + c8 + 4);
    uint4 o;
    o.x = pack2bf(a.x, a.y);
    o.y = pack2bf(a.z, a.w);
    o.z = pack2bf(b.x, b.y);
    o.w = pack2bf(b.z, b.w);
    *(uint4*)(dst + row * LDX + c8) = o;
  }
}

__device__ void phase_prep(const Params& p, char* lds) {
  float* tile = (float*)lds;
  transpose_cvt(p.w_qkv, p.wt_qkv, 2048, 2560, LDX, tile);
  transpose_cvt(p.w_o, p.wt_o, 2048, 2048, LDX, tile);
  for (int g = 0; g < 4; g++) transpose_cvt(p.pool_w + (size_t)g * 512 * 512, p.wt_pool + (size_t)g * 512 * LDP, 512, 512, LDP, tile);
  for (int l = 0; l < 2; l++) transpose_cvt(p.wq + (size_t)l * 2048 * 2048, p.wt_q + (size_t)l * 2048 * LDX, 2048, 2048, LDX, tile);
  cvt_bf16(p.subkeys, p.sk, (size_t)2 * 8 * 2 * 128 * 128);
  cvt_bf16_rows(p.x, p.xb, TOK);
  cvt_fp8_rows(p.pu, p.ub8, p.uinv, 2 * 16384);
  cvt_fp8_rows(p.pv, p.vb8, p.vinv, 2 * 16384);
}

__device__ __forceinline__ int swz(int row, int c) { return row * 128 + ((c ^ ((row >> 1) & 7)) << 4); }

__device__ __forceinline__ void dma16(const u16* g, char* l) {
  __builtin_amdgcn_global_load_lds((const unsigned*)g, (unsigned*)l, 16, 0, 0);
}
__device__ __forceinline__ void dma16u(const u16* gbase, unsigned voff, char* l) {
  __builtin_amdgcn_global_load_lds((const unsigned*)((const char*)gbase + voff), (unsigned*)l, 16, 0, 0);
}

__device__ __forceinline__ void gemm_mainloop(const u16* __restrict__ A, int lda, const u16* __restrict__ B, int ldb,
                                              int K, char* lds, f32x4 (&acc)[4][4]) {
  const int tid = otid(), lane = tid & 63, wave = tid >> 6;
  const int wm = wave >> 2, wn = wave & 3;
  const int fr = lane & 15, fq = lane >> 4;
  const int srow = tid >> 3, sp = tid & 7;
  const int sc = sp ^ ((srow >> 1) & 7);
  const unsigned va = (unsigned)(srow * lda + sc * 8) * 2u, vb = (unsigned)(srow * ldb + sc * 8) * 2u;
  const int soff = tid * 16;
  const int nk = K >> 6;
  const size_t sa = (size_t)64 * lda, sb = (size_t)64 * ldb;
#define GEMM_ISSUE(KT, STG)                                   \
  {                                                           \
    const int kn_ = (KT) * 64;                                \
    char* nb_ = lds + (STG) * 49152;                          \
    dma16u(A + kn_, va, nb_ + soff);                          \
    dma16u(A + sa + kn_, va, nb_ + soff + 8192);              \
    dma16u(B + kn_, vb, nb_ + 16384 + soff);                  \
    dma16u(B + sb + kn_, vb, nb_ + 16384 + soff + 8192);      \
    dma16u(B + 2 * sb + kn_, vb, nb_ + 16384 + soff + 16384); \
    dma16u(B + 3 * sb + kn_, vb, nb_ + 16384 + soff + 24576); \
  }
  GEMM_ISSUE(0, 0);
  GEMM_ISSUE(1, 1);
  int stg = 0;
  for (int kt = 0; kt < nk; kt++) {
    if (kt + 1 < nk) asm volatile("s_waitcnt vmcnt(6)" ::: "memory");
    else asm volatile("s_waitcnt vmcnt(0)" ::: "memory");
    asm volatile("s_waitcnt lgkmcnt(0)" ::: "memory");
    __builtin_amdgcn_s_barrier();
    if (kt + 2 < nk) {
      const int st2 = stg >= 1 ? stg - 1 : 2;
      GEMM_ISSUE(kt + 2, st2);
    }
    const char* ab = lds + stg * 49152;
    const char* bb = ab + 16384;
#pragma unroll
    for (int ks = 0; ks < 2; ks++) {
      const int co = ((ks * 4 + fq) ^ ((fr >> 1) & 7)) << 4;
      bfx8 wf[4], xf[4];
#pragma unroll
      for (int i = 0; i < 4; i++) wf[i] = *(const bfx8*)(bb + (wn * 64 + i * 16 + fr) * 128 + co);
#pragma unroll
      for (int j = 0; j < 4; j++) xf[j] = *(const bfx8*)(ab + (wm * 64 + j * 16 + fr) * 128 + co);
#pragma unroll
      for (int i = 0; i < 4; i++)
#pragma unroll
        for (int j = 0; j < 4; j++) acc[i][j] = __builtin_amdgcn_mfma_f32_16x16x32_bf16(wf[i], xf[j], acc[i][j], 0, 0, 0);
    }
    stg = stg == 2 ? 0 : stg + 1;
  }
#undef GEMM_ISSUE
  asm volatile("s_waitcnt lgkmcnt(0)" ::: "memory");
  __syncthreads();
}

__device__ __forceinline__ void gemm_mainloop256(const u16* __restrict__ A, int lda, const u16* __restrict__ B, int ldb,
                                                 int K, char* lds, f32x4 (&acc)[4][8]) {
  const int tid = otid(), lane = tid & 63, wave = tid >> 6;
  const int wm = wave >> 2, wn = wave & 3;
  const int fr = lane & 15, fq = lane >> 4;
  const int srow = tid >> 3, sp = tid & 7;
  const int sc = sp ^ ((srow >> 1) & 7);
  const unsigned va = (unsigned)(srow * lda + sc * 8) * 2u, vb = (unsigned)(srow * ldb + sc * 8) * 2u;
  const int soff = tid * 16;
  const int nk = K >> 6;
  const size_t sa = (size_t)64 * lda, sb = (size_t)64 * ldb;
#define GEMM_ISSUE2(KT, STG)                                  \
  {                                                           \
    const int kn_ = (KT) * 64;                                \
    char* nb_ = lds + (STG) * 65536;                          \
    dma16u(A + kn_, va, nb_ + soff);                          \
    dma16u(A + sa + kn_, va, nb_ + soff + 8192);              \
    dma16u(A + 2 * sa + kn_, va, nb_ + soff + 16384);         \
    dma16u(A + 3 * sa + kn_, va, nb_ + soff + 24576);         \
    dma16u(B + kn_, vb, nb_ + 32768 + soff);                  \
    dma16u(B + sb + kn_, vb, nb_ + 32768 + soff + 8192);      \
    dma16u(B + 2 * sb + kn_, vb, nb_ + 32768 + soff + 16384); \
    dma16u(B + 3 * sb + kn_, vb, nb_ + 32768 + soff + 24576); \
  }
  GEMM_ISSUE2(0, 0);
  for (int kt = 0; kt < nk; kt++) {
    asm volatile("s_waitcnt vmcnt(0)" ::: "memory");
    asm volatile("s_waitcnt lgkmcnt(0)" ::: "memory");
    __builtin_amdgcn_s_barrier();
    if (kt + 1 < nk) GEMM_ISSUE2(kt + 1, (kt + 1) & 1);
    const char* ab = lds + (kt & 1) * 65536;
    const char* bb = ab + 32768;
#pragma unroll
    for (int ks = 0; ks < 2; ks++) {
      const int co = ((ks * 4 + fq) ^ ((fr >> 1) & 7)) << 4;
      bfx8 wf[4];
#pragma unroll
      for (int i = 0; i < 4; i++) wf[i] = *(const bfx8*)(bb + (wn * 64 + i * 16 + fr) * 128 + co);
#pragma unroll
      for (int jj = 0; jj < 8; jj += 4) {
        bfx8 xf[4];
#pragma unroll
        for (int j = 0; j < 4; j++) xf[j] = *(const bfx8*)(ab + (wm * 128 + (jj + j) * 16 + fr) * 128 + co);
#pragma unroll
        for (int i = 0; i < 4; i++)
#pragma unroll
          for (int j = 0; j < 4; j++)
            acc[i][jj + j] = __builtin_amdgcn_mfma_f32_16x16x32_bf16(wf[i], xf[j], acc[i][jj + j], 0, 0, 0);
      }
    }
  }
#undef GEMM_ISSUE2
  asm volatile("s_waitcnt lgkmcnt(0)" ::: "memory");
  __syncthreads();
}

__device__ __forceinline__ bool tile_map(int it, int nM, int nN, int& mt, int& nt) {
  const int xcd = blockIdx.x & 7, local = blockIdx.x >> 3, nlocal = gridDim.x >> 3;
  const int per = (nM >> 3) * nN;
  const int idx = it * nlocal + local;
  if (idx >= per) return false;
  mt = xcd * (nM >> 3) + idx / nN;
  nt = idx % nN;
  return true;
}

__device__ void phase_qkv(const Params& p, char* lds) {
  const int nN = QKVD / 256;
  for (int it = 0;; it++) {
    int mt, nt;
    if (!tile_map(it, TOK / 128, nN, mt, nt)) break;
    const int m0 = mt * 128, n0 = nt * 256;
    f32x4 acc[4][4];
#pragma unroll
    for (int i = 0; i < 4; i++)
#pragma unroll
      for (int j = 0; j < 4; j++) acc[i][j] = (f32x4){0.f, 0.f, 0.f, 0.f};
    gemm_mainloop(p.xb + (size_t)m0 * LDX, LDX, p.wt_qkv + (size_t)n0 * LDX, LDX, DM, lds, acc);
    {
      const int tid = otid(), lane = tid & 63, wave = tid >> 6, wm = wave >> 2, wn = wave & 3, fr = lane & 15, fq = lane >> 4;
#pragma unroll
      for (int i = 0; i < 4; i++)
#pragma unroll
        for (int j = 0; j < 4; j++) {
          uint2 o;
          o.x = pack2bf(acc[i][j][0], acc[i][j][1]);
          o.y = pack2bf(acc[i][j][2], acc[i][j][3]);
          *(uint2*)(lds + (wm * 64 + j * 16 + fr) * 528 + (wn * 64 + i * 16 + fq * 4) * 2) = o;
        }
      __syncthreads();
#pragma unroll
      for (int rr = 0; rr < 8; rr++) {
        const int row = wave * 16 + rr * 2 + (lane >> 5), c8 = (lane & 31) * 8;
        const uint4 v = *(const uint4*)(lds + row * 528 + c8 * 2);
        *(uint4*)(p.qkv + (size_t)(m0 + row) * QKVD + n0 + c8) = v;
      }
      __syncthreads();
    }
  }
}

template <bool POOL>
__device__ void phase_gemm_resid(const Params& p, char* lds, const u16* A, const u16* Bt, const float* resid,
                                 const float* scale) {
  const int nN = DM / 256;
  for (int it = 0;; it++) {
    int mt, nt;
    if (!tile_map(it, TOK / 256, nN, mt, nt)) break;
    const int m0 = mt * 256, n0 = nt * 256;
    f32x4 acc[4][8];
#pragma unroll
    for (int i = 0; i < 4; i++)
#pragma unroll
      for (int j = 0; j < 8; j++) acc[i][j] = (f32x4){0.f, 0.f, 0.f, 0.f};
    if (POOL) {
      const int g = n0 >> 9;
      gemm_mainloop256(A + (size_t)m0 * LDX + g * 512, LDX, Bt + (size_t)g * 512 * LDP + (size_t)(n0 - g * 512) * LDP, LDP, 512,
                       lds, acc);
    } else {
      gemm_mainloop256(A + (size_t)m0 * LDX, LDX, Bt + (size_t)n0 * LDX, LDX, DM, lds, acc);
    }
    {
      const int tid = otid(), lane = tid & 63, wave = tid >> 6, wm = wave >> 2, wn = wave & 3, fr = lane & 15, fq = lane >> 4;
      const int c8 = (lane & 31) * 8, nb = n0 + c8;
      float4 sa4 = make_float4(1.f, 1.f, 1.f, 1.f), sb4 = sa4;
      if (POOL) {
        sa4 = *(const float4*)(scale + nb);
        sb4 = *(const float4*)(scale + nb + 4);
      }
#pragma unroll
      for (int half = 0; half < 2; half++) {
        if (wm == half) {
#pragma unroll
          for (int i = 0; i < 4; i++)
#pragma unroll
            for (int j = 0; j < 8; j++)
              *(float4*)(lds + ((j * 16 + fr) * 264 + wn * 64 + i * 16 + fq * 4) * 4) =
                  make_float4(acc[i][j][0], acc[i][j][1], acc[i][j][2], acc[i][j][3]);
        }
        __syncthreads();
        float4 ra[8], rb[8];
#pragma unroll
        for (int rr = 0; rr < 8; rr++) {
          const size_t m = (size_t)(m0 + half * 128 + wave * 16 + rr * 2 + (lane >> 5));
          if (true) {
            const uint4 w4 = *(const uint4*)(p.xb + m * LDX + nb);
            ra[rr] = make_float4(bflo(w4.x), bfhi(w4.x), bflo(w4.y), bfhi(w4.y));
            rb[rr] = make_float4(bflo(w4.z), bfhi(w4.z), bflo(w4.w), bfhi(w4.w));
          } else {
            ra[rr] = *(const float4*)(resid + m * DM + nb);
            rb[rr] = *(const float4*)(resid + m * DM + nb + 4);
          }
        }
#pragma unroll
        for (int rr = 0; rr < 8; rr++) {
          const int row = wave * 16 + rr * 2 + (lane >> 5);
          const float4 va = *(const float4*)(lds + (row * 264 + c8) * 4), vb = *(const float4*)(lds + (row * 264 + c8 + 4) * 4);
          uint4 o;
          o.x = pack2bf(ALPHA * ra[rr].x + va.x * sa4.x, ALPHA * ra[rr].y + va.y * sa4.y);
          o.y = pack2bf(ALPHA * ra[rr].z + va.z * sa4.z, ALPHA * ra[rr].w + va.w * sa4.w);
          o.z = pack2bf(ALPHA * rb[rr].x + vb.x * sb4.x, ALPHA * rb[rr].y + vb.y * sb4.y);
          o.w = pack2bf(ALPHA * rb[rr].z + vb.z * sb4.z, ALPHA * rb[rr].w + vb.w * sb4.w);
          *(uint4*)(p.yb + (size_t)(m0 + half * 128 + row) * DM + nb) = o;
        }
        __syncthreads();
      }
    }
  }
}

__device__ void phase_attn(const Params& p, char* lds) {
  const int tid = otid(), lane = tid & 63, wave = tid >> 6;
  const int r32 = lane & 31, h = lane >> 5;
  char* Kl = lds;
  u16* Vt = (u16*)(lds + 32768);
  for (int it = blockIdx.x; it < 512; it += gridDim.x) {
    const int b = it >> 6, n = (it >> 2) & 15, kvh = it & 3;
    const int tbase = b * 2048 + (n - 1) * 128;
    __syncthreads();
#pragma unroll
    for (int i = 0; i < 4; i++) {
      const int id = tid + NT * i, row = id >> 3, c = id & 7;
      uint4 v = make_uint4(0, 0, 0, 0);
      if (n > 0 || row >= 128) v = *(const uint4*)(p.qkv + (size_t)(tbase + row) * QKVD + 2048 + kvh * 64 + c * 8);
      *(uint4*)(Kl + swz(row, c)) = v;
    }
#pragma unroll
    for (int i = 0; i < 4; i++) {
      const int id = tid + NT * i, key = id & 255, dc = id >> 8;
      uint4 v = make_uint4(0, 0, 0, 0);
      if (n > 0 || key >= 128) v = *(const uint4*)(p.qkv + (size_t)(tbase + key) * QKVD + 2304 + kvh * 64 + dc * 8);
      u16* d = Vt + (dc * 8) * 260 + key;
      d[0 * 260] = (u16)(v.x & 0xFFFF);
      d[1 * 260] = (u16)(v.x >> 16);
      d[2 * 260] = (u16)(v.y & 0xFFFF);
      d[3 * 260] = (u16)(v.y >> 16);
      d[4 * 260] = (u16)(v.z & 0xFFFF);
      d[5 * 260] = (u16)(v.z >> 16);
      d[6 * 260] = (u16)(v.w & 0xFFFF);
      d[7 * 260] = (u16)(v.w >> 16);
    }
    __syncthreads();
    const int hq = kvh * 8 + wave;
    const float slope = exp2f(-0.25f * (float)(hq + 1));
    const float sink = p.sinks[hq];
#pragma unroll 1
    for (int qs = 0; qs < 4; qs++) {
      const size_t tq = (size_t)b * 2048 + n * 128 + qs * 32 + r32;
      bfx8 qf[4];
#pragma unroll
      for (int s = 0; s < 4; s++) qf[s] = *(const bfx8*)(p.qkv + tq * QKVD + hq * 64 + s * 16 + h * 8);
      f32x16 sacc[5];
#pragma unroll
      for (int kt = 0; kt < 5; kt++) {
#pragma unroll
        for (int r = 0; r < 16; r++) sacc[kt][r] = 0.f;
#pragma unroll
        for (int s = 0; s < 4; s++) {
          const bfx8 kf = *(const bfx8*)(Kl + swz(32 * (qs + kt) + r32, 2 * s + h));
          sacc[kt] = __builtin_amdgcn_mfma_f32_32x32x16_bf16(kf, qf[s], sacc[kt], 0, 0, 0);
        }
      }
      float mx = -1e30f;
      float slope_l = slope;
      int dbase = 128 + r32 - 4 * h;
      asm volatile("" : "+v"(slope_l), "+v"(dbase));
#pragma unroll
      for (int kt = 0; kt < 5; kt++)
#pragma unroll
        for (int r = 0; r < 16; r++) {
          const int kj = (r & 3) + 8 * (r >> 2) + 4 * h;
          const int dist = dbase - 32 * kt - ((r & 3) + 8 * (r >> 2));
          const int j = 32 * (qs + kt) + kj;
          const bool valid = (dist >= 0) && (dist < 128) && (n > 0 || j >= 128);
          const float sc = valid ? (sacc[kt][r] * 0.125f - slope_l * (float)dist) : -1e30f;
          sacc[kt][r] = sc;
          mx = fmaxf(mx, sc);
        }
      mx = fmaxf(mx, __shfl_xor(mx, 32));
      mx = fmaxf(mx, sink);
      float sum = 0.f;
#pragma unroll
      for (int kt = 0; kt < 5; kt++)
#pragma unroll
        for (int r = 0; r < 16; r++) {
          const float e = __expf(sacc[kt][r] - mx);
          sacc[kt][r] = e;
          sum += e;
        }
      sum += __shfl_xor(sum, 32);
      const float inv = 1.f / (sum + __expf(sink - mx));
      f32x16 oacc[2];
#pragma unroll
      for (int dt = 0; dt < 2; dt++)
#pragma unroll
        for (int r = 0; r < 16; r++) oacc[dt][r] = 0.f;
#pragma unroll
      for (int kt = 0; kt < 5; kt++)
#pragma unroll
        for (int s2 = 0; s2 < 2; s2++) {
          uint4 pw;
          pw.x = pack2bf(sacc[kt][8 * s2 + 0], sacc[kt][8 * s2 + 1]);
          pw.y = pack2bf(sacc[kt][8 * s2 + 2], sacc[kt][8 * s2 + 3]);
          pw.z = pack2bf(sacc[kt][8 * s2 + 4], sacc[kt][8 * s2 + 5]);
          pw.w = pack2bf(sacc[kt][8 * s2 + 6], sacc[kt][8 * s2 + 7]);
          const bfx8 pf = __builtin_bit_cast(bfx8, pw);
          const int key0 = 32 * (qs + kt) + 16 * s2 + 4 * h;
#pragma unroll
          for (int dt = 0; dt < 2; dt++) {
            const u16* vp = Vt + (dt * 32 + r32) * 260 + key0;
            const uint2 lo = *(const uint2*)vp;
            const uint2 hi = *(const uint2*)(vp + 8);
            const uint4 vw = make_uint4(lo.x, lo.y, hi.x, hi.y);
            oacc[dt] = __builtin_amdgcn_mfma_f32_32x32x16_bf16(__builtin_bit_cast(bfx8, vw), pf, oacc[dt], 0, 0, 0);
          }
        }
#pragma unroll
      for (int dt = 0; dt < 2; dt++)
#pragma unroll
        for (int g4 = 0; g4 < 4; g4++) {
          const int d = dt * 32 + 8 * g4 + 4 * h;
          uint2 o;
          o.x = pack2bf(oacc[dt][4 * g4 + 0] * inv, oacc[dt][4 * g4 + 1] * inv);
          o.y = pack2bf(oacc[dt][4 * g4 + 2] * inv, oacc[dt][4 * g4 + 3] * inv);
          *(uint2*)(p.att + tq * LDX + hq * 64 + d) = o;
        }
    }
  }
}

__device__ void phase_ln(const Params& p, const float* g, const float* bta, float* outf, bool write_bf) {
  const int tidq = otid(), lane = tidq & 63, wave = tidq >> 6;
  const int stride = gridDim.x * 8;
  int row = blockIdx.x * 8 + wave;
  uint4 w[4], wn[4];
#pragma unroll
  for (int c = 0; c < 4; c++) w[c] = *(const uint4*)(p.yb + (size_t)row * DM + c * 512 + lane * 8);
  while (row < TOK) {
    const int nrow = row + stride;
    const int lrow = nrow < TOK ? nrow : row;
#pragma unroll
    for (int c = 0; c < 4; c++) wn[c] = *(const uint4*)(p.yb + (size_t)lrow * DM + c * 512 + lane * 8);
    float v[32];
#pragma unroll
    for (int c = 0; c < 4; c++) {
      v[c * 8 + 0] = bflo(w[c].x); v[c * 8 + 1] = bfhi(w[c].x);
      v[c * 8 + 2] = bflo(w[c].y); v[c * 8 + 3] = bfhi(w[c].y);
      v[c * 8 + 4] = bflo(w[c].z); v[c * 8 + 5] = bfhi(w[c].z);
      v[c * 8 + 6] = bflo(w[c].w); v[c * 8 + 7] = bfhi(w[c].w);
    }
    float s = 0.f;
#pragma unroll
    for (int j = 0; j < 32; j++) s += v[j];
#pragma unroll
    for (int o = 32; o > 0; o >>= 1) s += __shfl_xor(s, o);
    const float mu = s * (1.f / DM);
    float q = 0.f;
#pragma unroll
    for (int j = 0; j < 32; j++) {
      v[j] -= mu;
      q += v[j] * v[j];
    }
#pragma unroll
    for (int o = 32; o > 0; o >>= 1) q += __shfl_xor(q, o);
    const float rstd = rsqrtf(q * (1.f / DM) + LN_EPS);
#pragma unroll
    for (int c = 0; c < 4; c++) {
      const int col = c * 512 + lane * 8;
      const float4 g0 = *(const float4*)(g + col), g1 = *(const float4*)(g + col + 4);
      const float4 b0 = *(const float4*)(bta + col), b1 = *(const float4*)(bta + col + 4);
      float4 o0, o1;
      o0.x = v[c * 8 + 0] * rstd * g0.x + b0.x; o0.y = v[c * 8 + 1] * rstd * g0.y + b0.y;
      o0.z = v[c * 8 + 2] * rstd * g0.z + b0.z; o0.w = v[c * 8 + 3] * rstd * g0.w + b0.w;
      o1.x = v[c * 8 + 4] * rstd * g1.x + b1.x; o1.y = v[c * 8 + 5] * rstd * g1.y + b1.y;
      o1.z = v[c * 8 + 6] * rstd * g1.z + b1.z; o1.w = v[c * 8 + 7] * rstd * g1.w + b1.w;
      if (write_bf) {
        uint4 ob;
        ob.x = pack2bf(o0.x, o0.y); ob.y = pack2bf(o0.z, o0.w);
        ob.z = pack2bf(o1.x, o1.y); ob.w = pack2bf(o1.z, o1.w);
        *(uint4*)(p.xb + (size_t)row * LDX + col) = ob;
      } else {
        *(float4*)(outf + (size_t)row * DM + col) = o0;
        *(float4*)(outf + (size_t)row * DM + col + 4) = o1;
      }
    }
#pragma unroll
    for (int c = 0; c < 4; c++) w[c] = wn[c];
    row = nrow;
  }
}

__device__ void phase_peer_route(const Params& p, char* lds, int layer) {
  const int tid_ = otid();
  char* ql = lds;
  char* skl = lds + 67584;
  float* keysl = (float*)lds;
  const u16* Wt = p.wt_q + (size_t)layer * 2048 * LDX;
  const int ntiles = (TOK / 128) * 8;
  for (int it = 0;; it++) {
    int mt, hd;
    if (!tile_map(it, TOK / 128, 8, mt, hd)) break;
    const int m0 = mt * 128, n0 = hd * 256;
    f32x4 acc[4][4];
#pragma unroll
    for (int i = 0; i < 4; i++)
#pragma unroll
      for (int j = 0; j < 4; j++) acc[i][j] = (f32x4){0.f, 0.f, 0.f, 0.f};
    __syncthreads();
    gemm_mainloop(p.xb + (size_t)m0 * LDX, LDX, Wt + (size_t)n0 * LDX, LDX, DM, lds, acc);
    int tid = tid_; asm volatile("" : "+v"(tid));
    const int lane = tid & 63, wave = tid >> 6, wm = wave >> 2, wn = wave & 3, fr = lane & 15, fq = lane >> 4;
    const int r32 = lane & 31, h32 = lane >> 5;
#pragma unroll
    for (int i = 0; i < 4; i++)
#pragma unroll
      for (int j = 0; j < 4; j++) {
        const int nl = wn * 64 + i * 16 + fq * 4, ml = wm * 64 + j * 16 + fr;
        uint2 o;
        o.x = pack2bf(acc[i][j][0], acc[i][j][1]);
        o.y = pack2bf(acc[i][j][2], acc[i][j][3]);
        *(uint2*)(ql + ml * 528 + nl * 2) = o;
      }
    {
      const u16* sksrc = p.sk + (size_t)(layer * 8 + hd) * 2 * 128 * 128;
#pragma unroll
      for (int i = 0; i < 8; i++) {
        const int id = tid + NT * i, row = id >> 4, c = id & 15;
        *(uint4*)(skl + row * 272 + c * 16) = *(const uint4*)(sksrc + row * 128 + c * 8);
      }
    }
    __syncthreads();
    const int pp = wave >> 2, tb = wave & 3;
    float L[16];
    {
      f32x16 sacc[4];
#pragma unroll
      for (int kt = 0; kt < 4; kt++)
#pragma unroll
        for (int r = 0; r < 16; r++) sacc[kt][r] = 0.f;
#pragma unroll
      for (int s = 0; s < 8; s++) {
        const bfx8 bq = *(const bfx8*)(ql + (tb * 32 + r32) * 528 + (pp * 128 + s * 16 + h32 * 8) * 2);
#pragma unroll
        for (int kt = 0; kt < 4; kt++) {
          const bfx8 ak = *(const bfx8*)(skl + (pp * 128 + kt * 32 + r32) * 272 + (s * 16 + h32 * 8) * 2);
          sacc[kt] = __builtin_amdgcn_mfma_f32_32x32x16_bf16(ak, bq, sacc[kt], 0, 0, 0);
        }
      }
      float G[16];
#pragma unroll
      for (int kt = 0; kt < 4; kt++) {
#pragma unroll
        for (int r = 0; r < 16; r++) {
          const unsigned key = 32 * kt + (r & 3) + 8 * (r >> 2) + 4 * h32;
          G[r] = __uint_as_float((__float_as_uint(sacc[kt][r]) & ~127u) | key);
        }
        sort16_desc(G);
        if (kt == 0) {
#pragma unroll
          for (int i = 0; i < 16; i++) L[i] = G[i];
        } else {
          merge16_desc(L, G);
        }
      }
    }
    {
      float O[16];
#pragma unroll
      for (int i = 0; i < 16; i++) O[i] = __shfl_xor(L[i], 32);
      merge16_desc(L, O);
    }
    __syncthreads();
    if (h32 == 0) {
#pragma unroll
      for (int i = 0; i < 16; i++) keysl[(tb * 32 + r32) * 33 + pp * 16 + i] = L[i];
    }
    __syncthreads();
    if (tid < 128) {
      float k0[16], k1[16], Bst[16];
#pragma unroll
      for (int i = 0; i < 16; i++) {
        k0[i] = clr7(keysl[tid * 33 + i]);
        k1[i] = clr7(keysl[tid * 33 + 16 + i]);
        Bst[i] = -INFINITY;
      }
#pragma unroll
      for (int i = 0; i < 16; i++)
#pragma unroll
        for (int j = 0; j < 16; j++)
          if ((i + 1) * (j + 1) <= 16) {
            const float v = k0[i] + k1[j];
            const float xv = __uint_as_float((__float_as_uint(v) & ~255u) | (unsigned)(i * 16 + j));
            INSERT16(Bst, xv);
          }
      float bv[16];
      int ei[16];
      float mxv = -INFINITY;
#pragma unroll
      for (int k = 0; k < 16; k++) {
        const unsigned pl = __float_as_uint(Bst[k]) & 255u;
        const float a = keysl[tid * 33 + (pl >> 4)], bq = keysl[tid * 33 + 16 + (pl & 15)];
        bv[k] = clr7(a) + clr7(bq);
        ei[k] = (int)((__float_as_uint(a) & 127u) * 128u + (__float_as_uint(bq) & 127u));
        mxv = fmaxf(mxv, bv[k]);
      }
      float ssum = 0.f;
#pragma unroll
      for (int k = 0; k < 16; k++) {
        bv[k] = __expf(bv[k] - mxv);
        ssum += bv[k];
      }
      const float inv = 1.f / ssum;
      const size_t ob = (size_t)(m0 + tid) * 128 + hd * 16;
#pragma unroll
      for (int k = 0; k < 16; k += 4)
        *(float4*)(p.pk_gate + ob + k) = make_float4(bv[k] * inv, bv[k + 1] * inv, bv[k + 2] * inv, bv[k + 3] * inv);
#pragma unroll
      for (int k = 0; k < 16; k += 8) {
        uint4 w4;
        w4.x = (unsigned)ei[k + 0] | ((unsigned)ei[k + 1] << 16);
        w4.y = (unsigned)ei[k + 2] | ((unsigned)ei[k + 3] << 16);
        w4.z = (unsigned)ei[k + 4] | ((unsigned)ei[k + 5] << 16);
        w4.w = (unsigned)ei[k + 6] | ((unsigned)ei[k + 7] << 16);
        *(uint4*)(p.pk_idx + ob + k) = w4;
      }
    }
  }
}

__device__ __forceinline__ float dot4f8(unsigned w, float x0, float x1, float x2, float x3, float a) {
  const f32x2 lo = __builtin_amdgcn_cvt_pk_f32_fp8((int)w, false);
  const f32x2 hi = __builtin_amdgcn_cvt_pk_f32_fp8((int)w, true);
  a = fmaf(lo.x, x0, a);
  a = fmaf(lo.y, x1, a);
  a = fmaf(hi.x, x2, a);
  a = fmaf(hi.y, x3, a);
  return a;
}
__device__ __forceinline__ void fma4f8(unsigned w, float a, float& f0, float& f1, float& f2, float& f3) {
  const f32x2 lo = __builtin_amdgcn_cvt_pk_f32_fp8((int)w, false);
  const f32x2 hi = __builtin_amdgcn_cvt_pk_f32_fp8((int)w, true);
  f0 = fmaf(a, lo.x, f0);
  f1 = fmaf(a, lo.y, f1);
  f2 = fmaf(a, hi.x, f2);
  f3 = fmaf(a, hi.y, f3);
}

__device__ __forceinline__ unsigned xcc_id() { return (unsigned)__builtin_amdgcn_s_getreg((3 << 11) | 20) & 7u; }
__device__ __forceinline__ int slice_order(unsigned x, int qi) {
  const int d = qi >> 1;
  return (int)(((x + d) & 7u) + ((qi & 1) ? 8u : 0u));
}
constexpr int WTOK = 8;
constexpr int ITEM_TOK = WTOK;
constexpr int NITEMS = TOK / ITEM_TOK;

__device__ __forceinline__ f32x2 pkfma(f32x2 a, f32x2 b, f32x2 c) { return __builtin_elementwise_fma(a, b, c); }
__device__ __forceinline__ f32x2 dot4f8p(unsigned w, f32x2 x01, f32x2 x23, f32x2 acc) {
  const f32x2 lo = __builtin_amdgcn_cvt_pk_f32_fp8((int)w, false);
  const f32x2 hi = __builtin_amdgcn_cvt_pk_f32_fp8((int)w, true);
  acc = pkfma(lo, x01, acc);
  acc = pkfma(hi, x23, acc);
  return acc;
}
__device__ __forceinline__ float dot16f8(const uint4 u, const f32x2 (&x)[8]) {
  f32x2 a = {0.f, 0.f};
  a = dot4f8p(u.x, x[0], x[1], a);
  a = dot4f8p(u.y, x[2], x[3], a);
  a = dot4f8p(u.z, x[4], x[5], a);
  a = dot4f8p(u.w, x[6], x[7], a);
  return a.x + a.y;
}
__device__ __forceinline__ void fma4f8p(unsigned w, f32x2 aa, f32x2& f01, f32x2& f23) {
  const f32x2 lo = __builtin_amdgcn_cvt_pk_f32_fp8((int)w, false);
  const f32x2 hi = __builtin_amdgcn_cvt_pk_f32_fp8((int)w, true);
  f01 = pkfma(lo, aa, f01);
  f23 = pkfma(hi, aa, f23);
}

struct Aux16 { float4 a, b, c, d; };
struct Idx16 { uint4 a, b; };
struct Tab4 { uint4 r[4]; };

template <bool VSIDE>
struct PeerItem {
  const Params& p;
  const unsigned char* tb;
  int s, g, w, lane;
  float* stage;
  __device__ __forceinline__ Idx16 load_idx(size_t tok) const {
    const uint4* ip = (const uint4*)(p.pk_idx + tok * 128 + g * 16);
    Idx16 r;
    r.a = ip[0]; r.b = ip[1];
    return r;
  }
  __device__ __forceinline__ Aux16 load_aux(size_t tok) const {
    Aux16 r;
    if (VSIDE) {
      const uint4* ap = (const uint4*)((const u16*)p.act + tok * 128 + g * 16);
      const uint4 a0 = ap[0], a1 = ap[1];
      r.a = make_float4(bflo(a0.x), bfhi(a0.x), bflo(a0.y), bfhi(a0.y));
      r.b = make_float4(bflo(a0.z), bfhi(a0.z), bflo(a0.w), bfhi(a0.w));
      r.c = make_float4(bflo(a1.x), bfhi(a1.x), bflo(a1.y), bfhi(a1.y));
      r.d = make_float4(bflo(a1.z), bfhi(a1.z), bflo(a1.w), bfhi(a1.w));
    } else {
      const uint4* xp = (const uint4*)(p.xb + tok * LDX + s * 128 + w * 16);
      const uint4 x0 = xp[0], x1 = xp[1];
      r.a = make_float4(bflo(x0.x), bfhi(x0.x), bflo(x0.y), bfhi(x0.y));
      r.b = make_float4(bflo(x0.z), bfhi(x0.z), bflo(x0.w), bfhi(x0.w));
      r.c = make_float4(bflo(x1.x), bfhi(x1.x), bflo(x1.y), bfhi(x1.y));
      r.d = make_float4(bflo(x1.z), bfhi(x1.z), bflo(x1.w), bfhi(x1.w));
    }
    return r;
  }
  __device__ __forceinline__ void issue(unsigned w0, unsigned w1, Tab4& t) const {
    t.r[0] = *(const uint4*)(tb + (size_t)((w0 & 0xFFFFu) << 7));
    t.r[1] = *(const uint4*)(tb + (size_t)((w0 >> 9) & 0xFFFFFF80u));
    t.r[2] = *(const uint4*)(tb + (size_t)((w1 & 0xFFFFu) << 7));
    t.r[3] = *(const uint4*)(tb + (size_t)((w1 >> 9) & 0xFFFFFF80u));
  }
  template <int Q>
  __device__ __forceinline__ void quarter(const Tab4& t, const Aux16& ax, f32x2 (&v)[8]) const {
    if (!VSIDE) {
      const f32x2 x[8] = {{ax.a.x, ax.a.y}, {ax.a.z, ax.a.w}, {ax.b.x, ax.b.y}, {ax.b.z, ax.b.w},
                          {ax.c.x, ax.c.y}, {ax.c.z, ax.c.w}, {ax.d.x, ax.d.y}, {ax.d.z, ax.d.w}};
      const float d0 = dot16f8(t.r[0], x), d1 = dot16f8(t.r[1], x), d2 = dot16f8(t.r[2], x), d3 = dot16f8(t.r[3], x);
      v[2 * Q] = (f32x2){d0, d1};
      v[2 * Q + 1] = (f32x2){d2, d3};
    } else {
      const float4 a4 = Q == 0 ? ax.a : Q == 1 ? ax.b : Q == 2 ? ax.c : ax.d;
      const float av[4] = {a4.x, a4.y, a4.z, a4.w};
#pragma unroll
      for (int j = 0; j < 4; j++) {
        const f32x2 aa = {av[j], av[j]};
        fma4f8p(t.r[j].x, aa, v[0], v[1]);
        fma4f8p(t.r[j].y, aa, v[2], v[3]);
        fma4f8p(t.r[j].z, aa, v[4], v[5]);
        fma4f8p(t.r[j].w, aa, v[6], v[7]);
      }
    }
  }
  __device__ __forceinline__ void finish(const f32x2 (&v2)[8], int tt) const {
    const float v[16] = {v2[0].x, v2[0].y, v2[1].x, v2[1].y, v2[2].x, v2[2].y, v2[3].x, v2[3].y,
                         v2[4].x, v2[4].y, v2[5].x, v2[5].y, v2[6].x, v2[6].y, v2[7].x, v2[7].y};
    const int sh = VSIDE ? 3 : 0;
    const bool c0 = ((lane >> sh) & 1) != 0, c1 = ((lane >> sh) & 2) != 0, c2 = ((lane >> sh) & 4) != 0;
    float r8[8], r4[4], r2[2];
#pragma unroll
    for (int i = 0; i < 8; i++) r8[i] = (c0 ? v[2 * i + 1] : v[2 * i]) + __shfl_xor(c0 ? v[2 * i] : v[2 * i + 1], 1 << sh);
#pragma unroll
    for (int i = 0; i < 4; i++) r4[i] = (c1 ? r8[2 * i + 1] : r8[2 * i]) + __shfl_xor(c1 ? r8[2 * i] : r8[2 * i + 1], 2 << sh);
#pragma unroll
    for (int i = 0; i < 2; i++) r2[i] = (c2 ? r4[2 * i + 1] : r4[2 * i]) + __shfl_xor(c2 ? r4[2 * i] : r4[2 * i + 1], 4 << sh);
    float* lw = stage + tt * 128 + (VSIDE ? (w * 16 + g) : (g * 16 + w));
    lw[0] = r2[0];
    lw[8] = r2[1];
  }
  __device__ __forceinline__ void flush(size_t tok0, int ntok) const {
    for (int tt = 0; tt < ntok; tt++) {
      float2 r = *(const float2*)(stage + tt * 128 + 2 * lane);
      if (!VSIDE) {
        *(unsigned*)(p.hpart + ((size_t)s * TOK + tok0 + tt) * 128 + 2 * lane) = pack2bf(r.x, r.y);
      } else {
        const unsigned xw = *(const unsigned*)(p.xb + (tok0 + tt) * LDX + s * 128 + 2 * lane);
        r.x += ALPHA * bflo(xw);
        r.y += ALPHA * bfhi(xw);
        *(unsigned*)(p.yb + (tok0 + tt) * DM + s * 128 + 2 * lane) = pack2bf(r.x, r.y);
      }
    }
  }
  template <bool ISSUE, bool TOPAUX, bool TOPIDX>
  __device__ __forceinline__ void step(Tab4 (&Q)[4], const Aux16& axCur, const Idx16& eNext, Aux16& axNext, Idx16& eNext2,
                                       size_t tokn, int tt) const {
    if (TOPAUX) axNext = load_aux(tokn);
    if (TOPIDX) eNext2 = load_idx(tokn + 1);
    f32x2 v[8];
#pragma unroll
    for (int j = 0; j < 8; j++) v[j] = (f32x2){0.f, 0.f};
    quarter<0>(Q[0], axCur, v);
    if (ISSUE) issue(eNext.a.x, eNext.a.y, Q[0]);
    quarter<1>(Q[1], axCur, v);
    if (ISSUE) issue(eNext.a.z, eNext.a.w, Q[1]);
    quarter<2>(Q[2], axCur, v);
    if (ISSUE) issue(eNext.b.x, eNext.b.y, Q[2]);
    quarter<3>(Q[3], axCur, v);
    if (ISSUE) issue(eNext.b.z, eNext.b.w, Q[3]);
    finish(v, tt);
  }
  __device__ __forceinline__ void run(size_t tok0) const {
    Tab4 Q[4];
    Idx16 eE = load_idx(tok0), eO;
    Aux16 axE = load_aux(tok0), axO;
    issue(eE.a.x, eE.a.y, Q[0]);
    issue(eE.a.z, eE.a.w, Q[1]);
    issue(eE.b.x, eE.b.y, Q[2]);
    issue(eE.b.z, eE.b.w, Q[3]);
    eO = load_idx(tok0 + 1);
#pragma unroll
    for (int t = 0; t < WTOK - 2; t += 2) {
      step<true, true, true>(Q, axE, eO, axO, eE, tok0 + t + 1, t);
      step<true, true, true>(Q, axO, eE, axE, eO, tok0 + t + 2, t + 1);
    }
    step<true, true, false>(Q, axE, eO, axO, eE, tok0 + WTOK - 1, WTOK - 2);
    step<false, false, false>(Q, axO, eE, axE, eO, tok0 + WTOK - 1, WTOK - 1);
    flush(tok0, WTOK);
  }
};

__device__ __forceinline__ unsigned wave_pull(unsigned* q, int lane) {
  unsigned v = 0;
  if (lane == 0) v = __hip_atomic_fetch_add(q, 1u, __ATOMIC_RELAXED, __HIP_MEMORY_SCOPE_AGENT);
  return (unsigned)__builtin_amdgcn_readfirstlane((int)v);
}

template <bool VSIDE>
__device__ void phase_peer_slices(const Params& p, char* lds, int layer, unsigned* queues) {
  const int tid = otid(), lane = tid & 63, wave = tid >> 6;
  const unsigned x = xcc_id();
  const unsigned char* tbase = (VSIDE ? p.vb8 : p.ub8) + (size_t)layer * 16384 * 2048;
  for (int qi = 0; qi < 16; qi++) {
    const int s = slice_order(x, qi < 2 ? (qi ^ (wave & 1)) : qi);
    PeerItem<VSIDE> pi{p, tbase + (size_t)s * (16384 * 128) + (lane & 7) * 16, s, lane >> 3, lane & 7, lane, (float*)(lds + 64 + wave * (WTOK * 512))};
    unsigned nxt = wave_pull(queues + s * 64, lane);
    while (nxt < (unsigned)NITEMS) {
      const unsigned cur = nxt;
      unsigned nv = 0;
      if (lane == 0) nv = __hip_atomic_fetch_add(queues + s * 64, 1u, __ATOMIC_RELAXED, __HIP_MEMORY_SCOPE_AGENT);
      pi.run((size_t)cur * ITEM_TOK);
      nxt = (unsigned)__builtin_amdgcn_readfirstlane((int)nv);
    }
  }
}

__device__ void phase_peer_act(const Params& p, int layer) {
  const float* uinv = p.uinv + layer * 16384;
  const float* vinv = p.vinv + layer * 16384;
  for (size_t i8 = (size_t)blockIdx.x * NT + otid(); i8 < (size_t)TOK * 16; i8 += (size_t)gridDim.x * NT) {
    const size_t i = i8 * 8;
    uint4 hp[16];
#pragma unroll
    for (int s = 0; s < 16; s++) hp[s] = *(const uint4*)(p.hpart + (size_t)s * TOK * 128 + i);
    const uint4 ew = *(const uint4*)(p.pk_idx + i);
    const float4 g0 = *(const float4*)(p.pk_gate + i), g1 = *(const float4*)(p.pk_gate + i + 4);
    float h[8];
#pragma unroll
    for (int j = 0; j < 8; j++) h[j] = 0.f;
#pragma unroll
    for (int s = 0; s < 16; s++) {
      h[0] += bflo(hp[s].x); h[1] += bfhi(hp[s].x);
      h[2] += bflo(hp[s].y); h[3] += bfhi(hp[s].y);
      h[4] += bflo(hp[s].z); h[5] += bfhi(hp[s].z);
      h[6] += bflo(hp[s].w); h[7] += bfhi(hp[s].w);
    }
    const int e[8] = {(int)(ew.x & 0xFFFF), (int)(ew.x >> 16), (int)(ew.y & 0xFFFF), (int)(ew.y >> 16),
                      (int)(ew.z & 0xFFFF), (int)(ew.z >> 16), (int)(ew.w & 0xFFFF), (int)(ew.w >> 16)};
    const float gt[8] = {g0.x, g0.y, g0.z, g0.w, g1.x, g1.y, g1.z, g1.w};
    float a[8];
#pragma unroll
    for (int j = 0; j < 8; j++) {
      const float hv = h[j] * uinv[e[j]];
      a[j] = gt[j] * 0.5f * hv * (1.f + erff(hv * 0.70710678118654752f)) * vinv[e[j]];
    }
    uint4 ab;
    ab.x = pack2bf(a[0], a[1]); ab.y = pack2bf(a[2], a[3]);
    ab.z = pack2bf(a[4], a[5]); ab.w = pack2bf(a[6], a[7]);
    *(uint4*)((u16*)p.act + i) = ab;
  }
}

template <int W>
__device__ __forceinline__ void poolmix_item(const Params& p, int t, int c8) {
  const int s = t & 2047;
  const int cnt = min(s + 1, W);
  const u16* xp = p.xb + (size_t)t * LDX + c8;
  uint4 b[W];
#pragma unroll
  for (int r = 0; r < W; r++) {
    const int rr = r < cnt ? r : 0;
    b[r] = *(const uint4*)(xp - (size_t)rr * LDX);
  }
  float a[8] = {bflo(b[0].x), bfhi(b[0].x), bflo(b[0].y), bfhi(b[0].y), bflo(b[0].z), bfhi(b[0].z), bflo(b[0].w), bfhi(b[0].w)};
  float sm[8];
#pragma unroll
  for (int j = 0; j < 8; j++) sm[j] = a[j];
#pragma unroll
  for (int r = 1; r < W; r++) {
    const float m = r < cnt ? 1.f : 0.f;
    sm[0] += m * bflo(b[r].x); sm[1] += m * bfhi(b[r].x);
    sm[2] += m * bflo(b[r].y); sm[3] += m * bfhi(b[r].y);
    sm[4] += m * bflo(b[r].z); sm[5] += m * bfhi(b[r].z);
    sm[6] += m * bflo(b[r].w); sm[7] += m * bfhi(b[r].w);
  }
  const float ic = 1.f / (float)cnt;
  uint4 o;
  o.x = pack2bf(sm[0] * ic - a[0], sm[1] * ic - a[1]);
  o.y = pack2bf(sm[2] * ic - a[2], sm[3] * ic - a[3]);
  o.z = pack2bf(sm[4] * ic - a[4], sm[5] * ic - a[5]);
  o.w = pack2bf(sm[6] * ic - a[6], sm[7] * ic - a[7]);
  *(uint4*)(p.att + (size_t)t * LDX + c8) = o;
}
__device__ void phase_poolmix(const Params& p) {
  for (size_t id = (size_t)blockIdx.x * NT + otid(); id < (size_t)TOK * 256; id += (size_t)gridDim.x * NT) {
    const int t = (int)(id >> 8), c8 = (int)(id & 255) * 8;
    const int grp = c8 >> 9;
    if (grp == 0) poolmix_item<2>(p, t, c8);
    else if (grp == 1) poolmix_item<4>(p, t, c8);
    else if (grp == 2) poolmix_item<8>(p, t, c8);
    else poolmix_item<16>(p, t, c8);
  }
}

__device__ __forceinline__ void run_phase(const Params& p, char* lds, int ph) {
  switch (ph) {
    case 0: phase_prep(p, lds); break;
    case 1: phase_qkv(p, lds); break;
    case 2: phase_attn(p, lds); break;
    case 3: phase_gemm_resid<false>(p, lds, p.att, p.wt_o, p.x, nullptr); break;
    case 4: phase_ln(p, p.ln_g, p.ln_b, nullptr, true); break;
    case 5: phase_peer_route(p, lds, 0); break;
    case 6: phase_peer_slices<false>(p, lds, 0, p.bar + 64 * 1); break;
    case 7: phase_peer_act(p, 0); break;
    case 8: phase_peer_slices<true>(p, lds, 0, p.bar + 64 * 17); break;
    case 9: phase_ln(p, p.ln_g + DM, p.ln_b + DM, nullptr, true); break;
    case 10: phase_poolmix(p); break;
    case 11: phase_gemm_resid<true>(p, lds, p.att, p.wt_pool, nullptr, p.pool_scale); break;
    case 12: phase_ln(p, p.ln_g + 2 * DM, p.ln_b + 2 * DM, nullptr, true); break;
    case 13: phase_peer_route(p, lds, 1); break;
    case 14: phase_peer_slices<false>(p, lds, 1, p.bar + 64 * 33); break;
    case 15: phase_peer_act(p, 1); break;
    case 16: phase_peer_slices<true>(p, lds, 1, p.bar + 64 * 49); break;
    case 17: phase_ln(p, p.ln_g + 3 * DM, p.ln_b + 3 * DM, p.out, false); break;
  }
}

#if MULTI
template <int PH>
__global__ void __launch_bounds__(NT) phase_kernel(Params p) {
  __shared__ __attribute__((aligned(16))) char lds[LDS_BYTES];
  run_phase(p, lds, PH);
}
#else
#define XB_TMO      128
#define XB_XCNT(j)  (256  + 64 * (j))
#define XB_XSUB(j)  (1280 + 64 * (j))
#define XB_XGEN(j)  (2304 + 64 * (j))
#define XB_TOP      3328
#define XB_TOPGEN   3392
#define XCD_BAR_WORDS 3456
#define XB_SPIN_CAP (1u << 22)
__device__ __forceinline__ unsigned xb_ld(unsigned* q) { return __hip_atomic_load(q, __ATOMIC_RELAXED, __HIP_MEMORY_SCOPE_AGENT); }
__device__ __forceinline__ unsigned xb_add(unsigned* q, unsigned v) { return __hip_atomic_fetch_add(q, v, __ATOMIC_RELAXED, __HIP_MEMORY_SCOPE_AGENT); }
__device__ __forceinline__ unsigned xb_xcc_id() { return (unsigned)__builtin_amdgcn_s_getreg((3 << 11) | 20) & 0xFu; }
#define XB_SPIN(cond, bar) do { unsigned _sp = 0; while (cond) { __builtin_amdgcn_s_sleep(1); \
    if ((++_sp & 255u) == 0u) { if (xb_ld(&(bar)[XB_TMO])) break; if (_sp > XB_SPIN_CAP) { atomicAdd(&(bar)[XB_TMO], 1u); break; } } } } while (0)
struct XcdBarrier { unsigned* bar; unsigned x; volatile unsigned* st; };
__device__ __forceinline__ XcdBarrier xcd_barrier_post(unsigned* bar, volatile unsigned* st) {
  XcdBarrier b; b.bar = bar; b.x = xb_xcc_id(); b.st = st;
  if (threadIdx.x == 0) (void)xb_add(&bar[XB_XCNT(b.x)], 1u);
  return b;
}
__device__ __forceinline__ void xcd_barrier_complete(unsigned* bar, unsigned x, unsigned& nloc, unsigned& nx) {
  const unsigned G = gridDim.x * gridDim.y * gridDim.z;
  unsigned sum, cnt, mine, sp = 0u;
  for (;;) {
    sum = 0u; cnt = 0u; mine = 0u;
#pragma unroll
    for (unsigned j = 0; j < 16; ++j) { const unsigned c = xb_ld(&bar[XB_XCNT(j)]); sum += c; cnt += (c > 0u) ? 1u : 0u; mine = (j == x) ? c : mine; }
    if (sum == G) break;
    __builtin_amdgcn_s_sleep(1);
    if ((++sp & 255u) == 0u) { if (xb_ld(&bar[XB_TMO])) break; if (sp > XB_SPIN_CAP) { atomicAdd(&bar[XB_TMO], 1u); break; } }
  }
  nloc = mine > 0u ? mine : 1u; nx = cnt > 0u ? cnt : 1u;
}
__device__ __forceinline__ void xcd_barrier(const XcdBarrier& b) {
  asm volatile("s_waitcnt vmcnt(0)" ::: "memory");
  __syncthreads();
  if (threadIdx.x == 0) {
    unsigned* bar = b.bar;
    __builtin_amdgcn_s_waitcnt(0);
    unsigned nloc = b.st[0], nx = b.st[1];
    if (nloc == 0u) { xcd_barrier_complete(bar, b.x, nloc, nx); b.st[0] = nloc; b.st[1] = nx; }
    const unsigned old = xb_add(&bar[XB_XSUB(b.x)], 1u);
    const unsigned gen = old / nloc;
    if (old + 1u == (gen + 1u) * nloc) {
      __builtin_amdgcn_fence(__ATOMIC_RELEASE, "agent");
      asm volatile("s_waitcnt vmcnt(0)" ::: "memory");
      const unsigned og = xb_add(&bar[XB_TOP], 1u);
      const unsigned tg = og / nx;
      if (og + 1u == (tg + 1u) * nx) xb_add(&bar[XB_TOPGEN], 1u);
      else XB_SPIN(xb_ld(&bar[XB_TOPGEN]) == tg, bar);
      __builtin_amdgcn_fence(__ATOMIC_ACQUIRE, "agent");
      xb_add(&bar[XB_XGEN(b.x)], 1u);
      asm volatile("s_waitcnt vmcnt(0)" ::: "memory");
    } else {
      XB_SPIN(xb_ld(&bar[XB_XGEN(b.x)]) == gen, bar);
      __builtin_amdgcn_fence(__ATOMIC_ACQUIRE, "agent");
      asm volatile("s_waitcnt vmcnt(0)" ::: "memory");
    }
  }
  __syncthreads();
}

__device__ __forceinline__ void grid_bar(unsigned* ctr, unsigned target) {
  asm volatile("s_waitcnt vmcnt(0)" ::: "memory");
  __syncthreads();
  if (threadIdx.x == 0) {
    __builtin_amdgcn_fence(__ATOMIC_RELEASE, "agent");
    asm volatile("s_waitcnt vmcnt(0)" ::: "memory");
    __hip_atomic_fetch_add(ctr, 1u, __ATOMIC_RELAXED, __HIP_MEMORY_SCOPE_AGENT);
    while (__hip_atomic_load(ctr, __ATOMIC_RELAXED, __HIP_MEMORY_SCOPE_AGENT) < target) __builtin_amdgcn_s_sleep(2);
    __builtin_amdgcn_fence(__ATOMIC_ACQUIRE, "agent");
    asm volatile("s_waitcnt vmcnt(0)" ::: "memory");
  }
  __syncthreads();
}

__global__ void __launch_bounds__(NT) mega_kernel(Params p) {
  __shared__ __attribute__((aligned(16))) char lds[LDS_BYTES + 16];
  cg::grid_group grid = cg::this_grid();
  volatile unsigned* xst = (volatile unsigned*)(lds + LDS_BYTES);
  if (threadIdx.x == 0) { xst[0] = 0u; xst[1] = 0u; }
  __syncthreads();
  const XcdBarrier xbar = xcd_barrier_post(p.xbar, xst);
  run_phase(p, lds, 0); grid.sync();
  run_phase(p, lds, 1); xcd_barrier(xbar);
  run_phase(p, lds, 2); xcd_barrier(xbar);
  run_phase(p, lds, 3); xcd_barrier(xbar);
  run_phase(p, lds, 4); xcd_barrier(xbar);
  run_phase(p, lds, 5); xcd_barrier(xbar);
  run_phase(p, lds, 6); xcd_barrier(xbar);
  run_phase(p, lds, 7); xcd_barrier(xbar);
  run_phase(p, lds, 8); xcd_barrier(xbar);
  run_phase(p, lds, 9); xcd_barrier(xbar);
  run_phase(p, lds, 10); xcd_barrier(xbar);
  run_phase(p, lds, 11); xcd_barrier(xbar);
  run_phase(p, lds, 12); xcd_barrier(xbar);
  run_phase(p, lds, 13); xcd_barrier(xbar);
  run_phase(p, lds, 14); xcd_barrier(xbar);
  run_phase(p, lds, 15); xcd_barrier(xbar);
  run_phase(p, lds, 16); xcd_barrier(xbar);
  run_phase(p, lds, 17);
}
#endif

extern "C" void kernel_launch(void* const* d_in, const int* in_sizes, int n_in, void* d_out, int out_size, void* d_ws,
                              size_t ws_size, hipStream_t stream) {
  Params p{};
  p.x = (const float*)d_in[0];
  p.w_qkv = (const float*)d_in[1];
  p.w_o = (const float*)d_in[2];
  p.sinks = (const float*)d_in[3];
  p.pool_w = (const float*)d_in[4];
  p.pool_scale = (const float*)d_in[5];
  p.ln_g = (const float*)d_in[6];
  p.ln_b = (const float*)d_in[7];
  p.wq = (const float*)d_in[8];
  p.subkeys = (const float*)d_in[9];
  p.pu = (const float*)d_in[10];
  p.pv = (const float*)d_in[11];
  p.out = (float*)d_out;
  char* w = (char*)d_ws;
  size_t off = 0;
  auto take = [&](size_t bytes) {
    char* r = w + off;
    off += (bytes + 255) & ~(size_t)255;
    return r;
  };
  p.wt_qkv = (u16*)take((size_t)2560 * LDX * 2);
  p.wt_o = (u16*)take((size_t)2048 * LDX * 2);
  p.wt_pool = (u16*)take((size_t)4 * 512 * LDP * 2);
  p.wt_q = (u16*)take((size_t)2 * 2048 * LDX * 2);
  p.sk = (u16*)take((size_t)2 * 8 * 2 * 128 * 128 * 2);
  p.ub8 = (unsigned char*)take((size_t)2 * 16384 * 2048);
  p.vb8 = (unsigned char*)take((size_t)2 * 16384 * 2048);
  p.uinv = (float*)take((size_t)2 * 16384 * 4);
  p.vinv = (float*)take((size_t)2 * 16384 * 4);
  p.xb = (u16*)take((size_t)TOK * LDX * 2);
  p.qkv = (u16*)take((size_t)TOK * QKVD * 2);
  p.att = (u16*)take((size_t)TOK * LDX * 2);
  p.yb = (u16*)take((size_t)TOK * DM * 2);
  p.pk_idx = (u16*)take((size_t)TOK * 128 * 2 + 4096);
  p.pk_gate = (float*)take((size_t)TOK * 128 * 4);
  p.bar = (unsigned*)take(65 * 256 + XCD_BAR_WORDS * 4);
  p.xbar = p.bar + 65 * 64;
  p.act = (float*)take((size_t)TOK * 128 * 4);
  p.hpart = (u16*)p.qkv;
  if (off > ws_size) {
    fprintf(stderr, "workspace too small: need %zu have %zu\n", off, ws_size);
    return;
  }
#if MULTI
  const int grid = 256;
  phase_kernel<0><<<grid, NT, 0, stream>>>(p);
  phase_kernel<1><<<grid, NT, 0, stream>>>(p);
  phase_kernel<2><<<grid, NT, 0, stream>>>(p);
  phase_kernel<3><<<grid, NT, 0, stream>>>(p);
  phase_kernel<4><<<grid, NT, 0, stream>>>(p);
  phase_kernel<5><<<grid, NT, 0, stream>>>(p);
  phase_kernel<6><<<grid, NT, 0, stream>>>(p);
  phase_kernel<7><<<grid, NT, 0, stream>>>(p);
  phase_kernel<8><<<grid, NT, 0, stream>>>(p);
  phase_kernel<9><<<grid, NT, 0, stream>>>(p);
  phase_kernel<10><<<grid, NT, 0, stream>>>(p);
  phase_kernel<11><<<grid, NT, 0, stream>>>(p);
  phase_kernel<12><<<grid, NT, 0, stream>>>(p);
  phase_kernel<13><<<grid, NT, 0, stream>>>(p);
  phase_kernel<14><<<grid, NT, 0, stream>>>(p);
  phase_kernel<15><<<grid, NT, 0, stream>>>(p);
  phase_kernel<16><<<grid, NT, 0, stream>>>(p);
  phase_kernel<17><<<grid, NT, 0, stream>>>(p);
#else
  static int grid_blocks = 0;
  if (!grid_blocks) {
    int dev = 0, cus = 0, per_cu = 0;
    hipGetDevice(&dev);
    hipDeviceGetAttribute(&cus, hipDeviceAttributeMultiprocessorCount, dev);
    hipOccupancyMaxActiveBlocksPerMultiprocessor(&per_cu, mega_kernel, NT, 0);
    if (per_cu > 1) per_cu = 1;
    grid_blocks = cus * per_cu;
  }
  hipMemsetAsync(p.bar, 0, 65 * 256 + XCD_BAR_WORDS * 4, stream);
  void* args[] = {&p};
  hipError_t e = hipLaunchCooperativeKernel((void*)mega_kernel, dim3(grid_blocks), dim3(NT), args, 0, stream);
  if (e != hipSuccess) fprintf(stderr, "cooperative launch failed: %s (grid %d)\n", hipGetErrorString(e), grid_blocks);
#endif
}
```
